# Optimizing an MI355X kernel written in HIP

```python
import jax, jax.numpy as jnp
from jax import lax
import numpy as np

D_MODEL = 1024
BATCH = 1
SEQ = 16384
DEPTH = 4
DEC_BATCH = 8
DEC_SEQ = 16
PAST_LEN = 1024

CHUNK = 64
HEAD_DIM = 64
A_HEADS = 8
A_KV_HEADS = 2
A_GROUP = A_HEADS // A_KV_HEADS
A_WINDOW = 128
A_BACK = A_WINDOW // CHUNK
B_HEADS = 8
B_BACK = 8
REL_CLIP = 256
X_HEADS = 4
X_HEAD_DIM = 128
N_MEM = 256
D_FF = 2816
CONV_W = 3
EPS = 1e-6
NEG = -1e30
A_Q = A_HEADS * HEAD_DIM
A_KV = A_KV_HEADS * HEAD_DIM
B_W = B_HEADS * HEAD_DIM
X_W = X_HEADS * X_HEAD_DIM
D_IN = A_Q + 2 * A_KV + 3 * B_W + 2 * D_MODEL

kernel_name = 'hybrid_streaming_swa_chunkband_step'


def rmsnorm(x, g):
    xf = x.astype(jnp.float32)
    y = xf * lax.rsqrt(jnp.mean(xf * xf, axis=-1, keepdims=True) + EPS)
    return (y * g.astype(jnp.float32)).astype(x.dtype)


def alibi_slopes():
    return jnp.asarray(np.exp2(-8.0 * np.arange(1, A_HEADS + 1) / A_HEADS), dtype=jnp.float32)


def alibi_bias(slopes, pos_q, pos_k):
    dist = jnp.abs(pos_q[:, None] - pos_k[None, :]).astype(jnp.float32)
    return -slopes.reshape(A_KV_HEADS, A_GROUP, 1, 1) * dist


def rel_pos_bias(table, pos_q, pos_k):
    idx = jnp.clip(pos_k[None, :] - pos_q[:, None], -REL_CLIP, REL_CLIP) + REL_CLIP
    return table.astype(jnp.float32)[:, idx][:, None]


def band_positions(back):
    pos_q = back * CHUNK + jnp.arange(CHUNK)
    pos_k = jnp.arange((back + 1) * CHUNK)
    return pos_q, pos_k


def band_valid_add(nc, back):
    kc = jnp.arange(nc)[:, None] - back + jnp.arange((back + 1) * CHUNK)[None, :] // CHUNK
    return jnp.where(kc >= 0, 0.0, NEG)[:, None, None, None, :]


def band_mask_add(pos_q, pos_k, back):
    cq = pos_q[:, None] // CHUNK
    ck = pos_k[None, :] // CHUNK
    return jnp.where((ck <= cq) & (ck >= cq - back), 0.0, NEG)


def chunk_band(t, back):
    nc = t.shape[1]
    pad = jnp.pad(t, [(0, 0), (back, 0)] + [(0, 0)] * (t.ndim - 2))
    band = jnp.stack([pad[:, j:j + nc] for j in range(back + 1)], axis=2)
    return band.reshape(t.shape[:2] + ((back + 1) * t.shape[2],) + t.shape[3:])


def attend(q, k, v, bias, mask_add, sink=None):
    s = jnp.einsum('...qkgd,...skd->...kgqs', q.astype(jnp.float32), k.astype(jnp.float32)) * (q.shape[-1] ** -0.5)
    if bias is not None:
        s = s + bias
    if mask_add is not None:
        s = s + mask_add
    if sink is not None:
        sk = jnp.broadcast_to(sink.astype(jnp.float32)[:, :, None, None], s.shape[:-1] + (1,))
        p = jax.nn.softmax(jnp.concatenate([s, sk], axis=-1), axis=-1)[..., :-1]
    else:
        p = jax.nn.softmax(s, axis=-1)
    return jnp.einsum('...kgqs,...skd->...qkgd', p.astype(v.dtype), v)


def project_in(h, w_in):
    z = h @ w_in
    c0 = A_Q
    c1 = c0 + A_KV
    c2 = c1 + A_KV
    c3 = c2 + B_W
    c4 = c3 + B_W
    c5 = c4 + B_W
    c6 = c5 + D_MODEL
    return jnp.split(z, [c0, c1, c2, c3, c4, c5, c6], axis=-1)


def merge_branches(oa, ob, ga, gb, w_o_a, w_o_b, w_out):
    m = jax.nn.sigmoid(ga) * (oa @ w_o_a) + jax.nn.sigmoid(gb) * (ob @ w_o_b)
    return m @ w_out


def mixer_prompt(h, slopes, w_in, sink, rel_table, w_o_a, w_o_b, w_out):
    bp, t, _ = h.shape
    nc = t // CHUNK
    qa, ka, va, qb, kb, vb, ga, gb = project_in(h, w_in)
    ka = ka.reshape(bp, t, A_KV_HEADS, HEAD_DIM)
    va = va.reshape(bp, t, A_KV_HEADS, HEAD_DIM)
    kb = kb.reshape(bp, t, B_HEADS, HEAD_DIM)
    vb = vb.reshape(bp, t, B_HEADS, HEAD_DIM)
    qa_c = qa.reshape(bp, nc, CHUNK, A_KV_HEADS, A_GROUP, HEAD_DIM)
    ka_b = chunk_band(ka.reshape(bp, nc, CHUNK, A_KV_HEADS, HEAD_DIM), A_BACK)
    va_b = chunk_band(va.reshape(bp, nc, CHUNK, A_KV_HEADS, HEAD_DIM), A_BACK)
    pq, pk = band_positions(A_BACK)
    oa = attend(qa_c, ka_b, va_b, alibi_bias(slopes, pq, pk), band_valid_add(nc, A_BACK),
                sink.reshape(A_KV_HEADS, A_GROUP)).reshape(bp, t, A_Q)
    qb_c = qb.reshape(bp, nc, CHUNK, B_HEADS, 1, HEAD_DIM)
    kb_b = chunk_band(kb.reshape(bp, nc, CHUNK, B_HEADS, HEAD_DIM), B_BACK)
    vb_b = chunk_band(vb.reshape(bp, nc, CHUNK, B_HEADS, HEAD_DIM), B_BACK)
    pq, pk = band_positions(B_BACK)
    ob = attend(qb_c, kb_b, vb_b, rel_pos_bias(rel_table, pq, pk), band_valid_add(nc, B_BACK)).reshape(bp, t, B_W)
    y = merge_branches(oa, ob, ga, gb, w_o_a, w_o_b, w_out)
    na = min(A_WINDOW, t)
    nb = min(B_BACK * CHUNK, t)
    return y, ka[:, t - na:], va[:, t - na:], kb[:, t - nb:], vb[:, t - nb:]


def mixer_sample(h, cak, cav, cbk, cbv, slopes, w_in, sink, rel_table, w_o_a, w_o_b, w_out):
    bd, tn, _ = h.shape
    qa, ka, va, qb, kb, vb, ga, gb = project_in(h, w_in)
    ka = ka.reshape(bd, tn, A_KV_HEADS, HEAD_DIM)
    va = va.reshape(bd, tn, A_KV_HEADS, HEAD_DIM)
    kb = kb.reshape(bd, tn, B_HEADS, HEAD_DIM)
    vb = vb.reshape(bd, tn, B_HEADS, HEAD_DIM)
    pos_q = PAST_LEN + jnp.arange(tn)
    la = cak.shape[1]
    pk_a = jnp.concatenate([PAST_LEN - la + jnp.arange(la), pos_q])
    oa = attend(qa.reshape(bd, tn, A_KV_HEADS, A_GROUP, HEAD_DIM),
                jnp.concatenate([cak.astype(ka.dtype), ka], axis=1),
                jnp.concatenate([cav.astype(va.dtype), va], axis=1),
                alibi_bias(slopes, pos_q, pk_a), band_mask_add(pos_q, pk_a, A_BACK),
                sink.reshape(A_KV_HEADS, A_GROUP)).reshape(bd, tn, A_Q)
    lb = cbk.shape[1]
    pk_b = jnp.concatenate([PAST_LEN - lb + jnp.arange(lb), pos_q])
    ob = attend(qb.reshape(bd, tn, B_HEADS, 1, HEAD_DIM),
                jnp.concatenate([cbk.astype(kb.dtype), kb], axis=1),
                jnp.concatenate([cbv.astype(vb.dtype), vb], axis=1),
                rel_pos_bias(rel_table, pos_q, pk_b), band_mask_add(pos_q, pk_b, B_BACK)).reshape(bd, tn, B_W)
    y = merge_branches(oa, ob, ga, gb, w_o_a, w_o_b, w_out)
    return y, ka, va, kb, vb


def mem_kv(mem, g, w_k, w_v):
    b, m, _ = mem.shape
    hm = rmsnorm(mem, g)
    return ((hm @ w_k).reshape(b, m, X_HEADS, X_HEAD_DIM), (hm @ w_v).reshape(b, m, X_HEADS, X_HEAD_DIM))


def cross_attn(h, mk, mv, w_q, w_o):
    b, t, _ = h.shape
    q = (h @ w_q).reshape(b, t, X_HEADS, 1, X_HEAD_DIM)
    o = attend(q, mk.astype(h.dtype), mv.astype(h.dtype), None, None)
    return o.reshape(b, t, X_W) @ w_o


def conv_ffn(h, conv_state, w_up, w_conv, b_conv, w_down):
    u = h @ w_up
    t = u.shape[1]
    ext = jnp.concatenate([conv_state.astype(u.dtype), u], axis=1)
    c = b_conv
    for j in range(CONV_W):
        c = c + ext[:, j:j + t] * w_conv[j]
    gate, up = jnp.split(c, 2, axis=-1)
    return (jax.nn.silu(gate) * up) @ w_down, ext[:, t:]


def setup_inputs(seed: int = 0) -> dict:
    key = jax.random.key(seed)
    ks = jax.random.split(key, 32)

    def nrm(k, shape, scale=1.0):
        return scale * jax.random.normal(k, shape, jnp.float32)

    la = min(A_WINDOW, PAST_LEN)
    lb = min(B_BACK * CHUNK, PAST_LEN)
    return {
        'x_prompt': nrm(ks[0], (BATCH, SEQ, D_MODEL)),
        'x_sample': nrm(ks[1], (DEC_BATCH, DEC_SEQ, D_MODEL)),
        'mem_prompt': nrm(ks[2], (BATCH, N_MEM, D_MODEL)),
        'cache_a_k': nrm(ks[3], (DEPTH, DEC_BATCH, la, A_KV_HEADS, HEAD_DIM)),
        'cache_a_v': nrm(ks[4], (DEPTH, DEC_BATCH, la, A_KV_HEADS, HEAD_DIM)),
        'cache_b_k': nrm(ks[5], (DEPTH, DEC_BATCH, lb, B_HEADS, HEAD_DIM)),
        'cache_b_v': nrm(ks[6], (DEPTH, DEC_BATCH, lb, B_HEADS, HEAD_DIM)),
        'cache_mem_k': nrm(ks[7], (DEPTH, DEC_BATCH, N_MEM, X_HEADS, X_HEAD_DIM)),
        'cache_mem_v': nrm(ks[8], (DEPTH, DEC_BATCH, N_MEM, X_HEADS, X_HEAD_DIM)),
        'state_conv': nrm(ks[9], (DEPTH, DEC_BATCH, CONV_W - 1, 2 * D_FF)),
        'g_mix': 1.0 + nrm(ks[10], (DEPTH, D_MODEL), 0.02),
        'w_mix_in': nrm(ks[11], (DEPTH, D_MODEL, D_IN), D_MODEL ** -0.5),
        'a_sink': nrm(ks[12], (DEPTH, A_HEADS), 0.5),
        'b_rel_bias': nrm(ks[13], (DEPTH, B_HEADS, 2 * REL_CLIP + 1), 0.1),
        'w_o_a': nrm(ks[14], (DEPTH, A_Q, D_MODEL), A_Q ** -0.5),
        'w_o_b': nrm(ks[15], (DEPTH, B_W, D_MODEL), B_W ** -0.5),
        'w_mix_out': nrm(ks[16], (DEPTH, D_MODEL, D_MODEL), D_MODEL ** -0.5),
        'g_xattn': 1.0 + nrm(ks[17], (DEPTH, D_MODEL), 0.02),
        'g_mem': 1.0 + nrm(ks[18], (DEPTH, D_MODEL), 0.02),
        'w_xq': nrm(ks[19], (DEPTH, D_MODEL, X_W), D_MODEL ** -0.5),
        'w_xk': nrm(ks[20], (DEPTH, D_MODEL, X_W), D_MODEL ** -0.5),
        'w_xv': nrm(ks[21], (DEPTH, D_MODEL, X_W), D_MODEL ** -0.5),
        'w_xo': nrm(ks[22], (DEPTH, X_W, D_MODEL), X_W ** -0.5),
        'g_ffn': 1.0 + nrm(ks[23], (DEPTH, D_MODEL), 0.02),
        'w_up': nrm(ks[24], (DEPTH, D_MODEL, 2 * D_FF), D_MODEL ** -0.5),
        'w_conv': nrm(ks[25], (DEPTH, CONV_W, 2 * D_FF), CONV_W ** -0.5),
        'b_conv': nrm(ks[26], (DEPTH, 2 * D_FF), 0.01),
        'w_down': nrm(ks[27], (DEPTH, D_FF, D_MODEL), D_FF ** -0.5),
        'g_final': 1.0 + nrm(ks[28], (D_MODEL,), 0.02),
    }


def reference(x_prompt, x_sample, mem_prompt, cache_a_k, cache_a_v, cache_b_k, cache_b_v,
              cache_mem_k, cache_mem_v, state_conv, g_mix, w_mix_in, a_sink, b_rel_bias,
              w_o_a, w_o_b, w_mix_out, g_xattn, g_mem, w_xq, w_xk, w_xv, w_xo,
              g_ffn, w_up, w_conv, b_conv, w_down, g_final):
    slopes = alibi_slopes()
    xp = x_prompt
    xs = x_sample
    l_pa_k, l_pa_v, l_pb_k, l_pb_v, l_pm_k, l_pm_v, l_pconv = [], [], [], [], [], [], []
    l_sa_k, l_sa_v, l_sb_k, l_sb_v, l_sconv = [], [], [], [], []
    for l in range(DEPTH):
        wts = (w_mix_in[l], a_sink[l], b_rel_bias[l], w_o_a[l], w_o_b[l], w_mix_out[l])
        y, ak, av, bk, bv = mixer_prompt(rmsnorm(xp, g_mix[l]), slopes, *wts)
        xp = xp + y
        mk, mv = mem_kv(mem_prompt, g_mem[l], w_xk[l], w_xv[l])
        xp = xp + cross_attn(rmsnorm(xp, g_xattn[l]), mk, mv, w_xq[l], w_xo[l])
        zero_state = jnp.zeros((xp.shape[0], CONV_W - 1, 2 * D_FF), xp.dtype)
        y, cp = conv_ffn(rmsnorm(xp, g_ffn[l]), zero_state, w_up[l], w_conv[l], b_conv[l], w_down[l])
        xp = xp + y
        l_pa_k.append(ak); l_pa_v.append(av); l_pb_k.append(bk); l_pb_v.append(bv)
        l_pm_k.append(mk); l_pm_v.append(mv); l_pconv.append(cp)
        y, ak, av, bk, bv = mixer_sample(rmsnorm(xs, g_mix[l]), cache_a_k[l], cache_a_v[l],
                                         cache_b_k[l], cache_b_v[l], slopes, *wts)
        xs = xs + y
        xs = xs + cross_attn(rmsnorm(xs, g_xattn[l]), cache_mem_k[l], cache_mem_v[l], w_xq[l], w_xo[l])
        y, cs = conv_ffn(rmsnorm(xs, g_ffn[l]), state_conv[l], w_up[l], w_conv[l], b_conv[l], w_down[l])
        xs = xs + y
        l_sa_k.append(ak); l_sa_v.append(av); l_sb_k.append(bk); l_sb_v.append(bv); l_sconv.append(cs)
    y_prompt = rmsnorm(xp, g_final)
    y_sample = rmsnorm(xs, g_final)
    pa_k = jnp.stack(l_pa_k)
    pa_v = jnp.stack(l_pa_v)
    pb_k = jnp.stack(l_pb_k)
    pb_v = jnp.stack(l_pb_v)
    pm_k = jnp.stack(l_pm_k)
    pm_v = jnp.stack(l_pm_v)
    pconv = jnp.stack(l_pconv)
    sa_k = jnp.stack(l_sa_k)
    sa_v = jnp.stack(l_sa_v)
    sb_k = jnp.stack(l_sb_k)
    sb_v = jnp.stack(l_sb_v)
    sconv = jnp.stack(l_sconv)
    return (y_prompt, y_sample, pa_k, pa_v, pb_k, pb_v, pm_k, pm_v, pconv, sa_k, sa_v, sb_k, sb_v, sconv)
```

```cpp
#include <hip/hip_runtime.h>
#include <hip/hip_cooperative_groups.h>
#include <cstdio>
#include <cstdint>
namespace cg = cooperative_groups;

#define DI __device__ __forceinline__
typedef unsigned short bf16_t;
typedef _Float16 bf16x8 __attribute__((ext_vector_type(8)));
typedef short s16x4 __attribute__((ext_vector_type(4)));
typedef float f32x16 __attribute__((ext_vector_type(16)));
typedef float f32x4 __attribute__((ext_vector_type(4)));
typedef float f32x2 __attribute__((ext_vector_type(2)));
typedef _Float16 bf2_t __attribute__((ext_vector_type(2)));
typedef unsigned u32x4 __attribute__((ext_vector_type(4)));
typedef unsigned u32x2 __attribute__((ext_vector_type(2)));

#define MFMA32(a, b, c) __builtin_amdgcn_mfma_f32_32x32x16_f16((a), (b), (c), 0, 0, 0)

constexpr int DM = 1024, SEQ = 16384, NSMP = 128, MROWS = SEQ + NSMP, NTILE = SEQ / 64, NHALO = MROWS / 64, DEPTH = 4, NTHR = 512, NWAVE = NTHR / 64;
constexpr int DIN = 4352, DFF = 2816, DFF2 = 5632, PRIVW = 5632;
constexpr int PC_QA = 0, PC_QB = 512, PC_GA = 1024, PC_GB = 2048, PC_OA = 3072, PC_OB = 3584, PC_M = 4096, PC_QX = 5120, PC_OX = 0;
constexpr size_t PW_IN = 0, PW_OA = PW_IN + (size_t)DM * DIN, PW_OB = PW_OA + 512 * 1024, PW_OUT = PW_OB + 512 * 1024,
                 PW_XQ = PW_OUT + 1024 * 1024, PW_XO = PW_XQ + 1024 * 512, PW_UP = PW_XO + 512 * 1024,
                 PW_DOWN = PW_UP + (size_t)DM * DFF2, PW_LAYER = PW_DOWN + (size_t)DFF * DM;
constexpr size_t OFF_WP = 0;
constexpr size_t OFF_XB = OFF_WP + PW_LAYER * 2 * DEPTH;
constexpr size_t OFF_PRIV = OFF_XB + (size_t)MROWS * DM * 2;
constexpr size_t OFF_KA = OFF_PRIV + (size_t)MROWS * PRIVW * 2;
constexpr size_t OFF_VTA = OFF_KA + (size_t)MROWS * 128 * 2;
constexpr size_t OFF_KB = OFF_VTA + (size_t)MROWS * 128 * 2;
constexpr size_t OFF_VTB = OFF_KB + (size_t)MROWS * 512 * 2;
constexpr size_t OFF_UHALO = OFF_VTB + (size_t)MROWS * 512 * 2;
constexpr size_t OFF_MEMB = OFF_UHALO + (size_t)NHALO * 2 * DFF2 * 4;
constexpr size_t OFF_MK = OFF_MEMB + 256 * 1024 * 2;
constexpr size_t OFF_MVT = OFF_MK + (size_t)DEPTH * 256 * 512 * 2;
constexpr size_t OFF_SKA = OFF_MVT + (size_t)DEPTH * 256 * 512 * 2;
constexpr size_t OFF_SVTA = OFF_SKA + 8 * 128 * 128 * 2;
constexpr size_t OFF_SKB = OFF_SVTA + 8 * 128 * 128 * 2;
constexpr size_t OFF_SVTB = OFF_SKB + 8 * 512 * 512 * 2;
constexpr size_t OFF_SMK = OFF_SVTB + 8 * 512 * 512 * 2;
constexpr size_t OFF_SMVT = OFF_SMK + 8 * 256 * 512 * 2;
constexpr size_t OFF_BAR = OFF_SMVT + 8 * 256 * 512 * 2;
constexpr size_t WS_TOTAL = OFF_BAR + 16384;
constexpr size_t O_Y = 0, O_PAK = (size_t)MROWS * DM, O_PAV = O_PAK + 4 * 128 * 128, O_PBK = O_PAV + 4 * 128 * 128, O_PBV = O_PBK + 4 * 512 * 512,
                 O_PMK = O_PBV + 4 * 512 * 512, O_PMV = O_PMK + 4 * 256 * 512, O_PCONV = O_PMV + 4 * 256 * 512, O_SAK = O_PCONV + 4 * 2 * DFF2,
                 O_SAV = O_SAK + 4 * 128 * 128, O_SBK = O_SAV + 4 * 128 * 128, O_SBV = O_SBK + 4 * 128 * 512, O_SCONV = O_SBV + 4 * 128 * 512;

constexpr int A_CHUNK = 128, A_LD = A_CHUNK * 2 + 16, A_BUF = 96 * A_LD;
constexpr int ARES_LD = 1024 * 2 + 16;
constexpr int LDS_BYTES = 64 * ARES_LD > 2 * A_BUF ? 64 * ARES_LD : 2 * A_BUF;
constexpr float LOG2E = 1.4426950408889634f;
constexpr int NT = 2, UW = NT * 32;

struct Params {
    const float* in[29];
    float* out;
    unsigned char* ws;
};

DI void lds_barrier() { asm volatile("s_waitcnt lgkmcnt(0)\n\ts_barrier" ::: "memory"); }
DI int otid() { int t = threadIdx.x; asm volatile("" : "+v"(t)); return t; }
DI unsigned pk2(float lo, float hi) { f32x2 v = {lo, hi}; bf2_t b = __builtin_convertvector(v, bf2_t); return __builtin_bit_cast(unsigned, b); }
DI bf16_t cv1(float x) { return (bf16_t)(pk2(x, 0.f) & 0xffffu); }
DI float bf2f(bf16_t v) { return (float)__builtin_bit_cast(_Float16, v); }
DI int crow(int i, int h) { return (i & 3) + 8 * (i >> 2) + 4 * h; }
DI float sigm(float x) { return 1.f / (1.f + __expf(-x)); }

DI void pack_w(const float* __restrict__ W, const float* __restrict__ g, int K, int N, bf16_t* dst, int mode, int gtid, int gthreads) {
    const int KS = K / 16, NTt = N / 32, total = NTt * KS * 16;
    for (int idx = gtid; idx < total; idx += gthreads) {
        const int rq = idx & 7, h = (idx >> 3) & 1, blk = idx >> 4, nt = blk % NTt, ks = blk / NTt;
        const int n = nt * 32 + 4 * rq, k0 = ks * 16 + 8 * h;
        float sc = 1.f;
        if (mode == 1) { if (n < 512 || (n >= 768 && n < 1280)) sc = 0.125f; }
        else if (mode == 2) sc = 0.08838834764831845f;
        f32x4 v[8];
#pragma unroll
        for (int j = 0; j < 8; ++j) v[j] = *(const f32x4*)(W + (size_t)(k0 + j) * N + n) * ((g ? g[k0 + j] : 1.f) * sc);
        u32x4* o = (u32x4*)dst + (size_t)blk * 64 + h * 32 + 4 * rq;
#pragma unroll
        for (int e = 0; e < 4; ++e) { u32x4 w = {pk2(v[0][e], v[1][e]), pk2(v[2][e], v[3][e]), pk2(v[4][e], v[5][e]), pk2(v[6][e], v[7][e])}; o[e] = w; }
    }
}
DI void conv_kp(const float* __restrict__ src, bf16_t* dst, int B, int R, int H, int HD, int gtid, int gthreads) {
    const int C = H * HD, C8 = C / 8, KSQ = HD / 16, total = B * R * C8;
    for (int idx = gtid; idx < total; idx += gthreads) {
        const int c8 = idx % C8, t2 = idx / C8, t = t2 % R, b = t2 / R;
        const f32x4* sp = (const f32x4*)(src + ((size_t)b * R + t) * C + c8 * 8);
        const f32x4 v0 = sp[0], v1 = sp[1];
        const int col = c8 * 8, hd = col / HD, d = col % HD;
        const size_t o16 = ((((size_t)b * (R / 32) + (t >> 5)) * H + hd) * KSQ + (d >> 4)) * 64 + (t & 31) + 32 * ((d >> 3) & 1);
        u32x4 w = {pk2(v0[0], v0[1]), pk2(v0[2], v0[3]), pk2(v1[0], v1[1]), pk2(v1[2], v1[3])};
        ((u32x4*)dst)[o16] = w;
    }
}
DI void conv_vp(const float* __restrict__ src, bf16_t* dst, int B, int R, int C, int gtid, int gthreads) {
    const int DTt = C / 32, total = B * (R / 16) * DTt * 64;
    for (int idx = gtid; idx < total; idx += gthreads) {
        const int lane = idx & 63, f = idx >> 6, sp_ = f & 1, f2 = f >> 1, dd = f2 % DTt, f3 = f2 / DTt, tb = f3 % (R / 32), b = f3 / (R / 32);
        const int r = lane & 31, h = lane >> 5;
        const float* s0 = src + ((size_t)b * R + 32 * tb + 16 * sp_ + 4 * h) * C + dd * 32 + r;
        float v[8];
#pragma unroll
        for (int j = 0; j < 8; ++j) v[j] = s0[(size_t)(8 * (j >> 2) + (j & 3)) * C];
        u32x4 w = {pk2(v[0], v[1]), pk2(v[2], v[3]), pk2(v[4], v[5]), pk2(v[6], v[7])};
        ((u32x4*)dst)[idx] = w;
    }
}
DI void conv_sample_caches(const Params& p, int l, int gthreads) {
    unsigned char* ws = p.ws;
    const int gtid = blockIdx.x * NTHR + otid();
    conv_kp(p.in[3] + (size_t)l * 8 * 128 * 128, (bf16_t*)(ws + OFF_SKA), 8, 128, 2, 64, gtid, gthreads);
    conv_vp(p.in[4] + (size_t)l * 8 * 128 * 128, (bf16_t*)(ws + OFF_SVTA), 8, 128, 128, gtid, gthreads);
    conv_kp(p.in[5] + (size_t)l * 8 * 512 * 512, (bf16_t*)(ws + OFF_SKB), 8, 512, 8, 64, gtid, gthreads);
    conv_vp(p.in[6] + (size_t)l * 8 * 512 * 512, (bf16_t*)(ws + OFF_SVTB), 8, 512, 512, gtid, gthreads);
    conv_kp(p.in[7] + (size_t)l * 8 * 256 * 512, (bf16_t*)(ws + OFF_SMK), 8, 256, 4, 128, gtid, gthreads);
    conv_vp(p.in[8] + (size_t)l * 8 * 256 * 512, (bf16_t*)(ws + OFF_SMVT), 8, 256, 512, gtid, gthreads);
}
template <int MODE, int MT> DI void norm_rows(const float* src, const float* src2, float* x, int d2, bf16_t* xb, const float* __restrict__ g) {
    const int tid_ = otid(), wave = tid_ >> 6, lane = tid_ & 63;
    for (int rb = 0; rb < MT; ++rb) {
        f32x4 v[4][4]; float ss[4];
#pragma unroll
        for (int q = 0; q < 4; ++q) {
            const int row = wave * (MT * 4) + rb * 4 + q, grow = row + (row >= 64 ? d2 : 0);
            const float* s = x + (size_t)grow * DM;
            if (MODE == 0) { s = src + (size_t)row * DM; if (MT == 3 && row >= 64) s = src2 + (size_t)(row - 64) * DM; }
            ss[q] = 0.f;
#pragma unroll
            for (int i = 0; i < 4; ++i) { v[q][i] = *(const f32x4*)(s + i * 256 + lane * 4); ss[q] += v[q][i][0] * v[q][i][0] + v[q][i][1] * v[q][i][1] + v[q][i][2] * v[q][i][2] + v[q][i][3] * v[q][i][3]; }
        }
#pragma unroll
        for (int o = 32; o >= 1; o >>= 1)
#pragma unroll
            for (int q = 0; q < 4; ++q) ss[q] += __shfl_xor(ss[q], o);
#pragma unroll
        for (int q = 0; q < 4; ++q) {
            const int row = wave * (MT * 4) + rb * 4 + q, grow = row + (row >= 64 ? d2 : 0);
            const float rstd = rsqrtf(ss[q] * (1.f / DM) + 1e-6f);
#pragma unroll
            for (int i = 0; i < 4; ++i) {
                if (MODE == 0) *(f32x4*)(x + (size_t)grow * DM + i * 256 + lane * 4) = v[q][i];
                if (MODE == 2) { f32x4 gg = *(const f32x4*)(g + i * 256 + lane * 4); *(f32x4*)(x + (size_t)grow * DM + i * 256 + lane * 4) = v[q][i] * rstd * gg; }
                else { u32x2 o = {pk2(v[q][i][0] * rstd, v[q][i][1] * rstd), pk2(v[q][i][2] * rstd, v[q][i][3] * rstd)}; *(u32x2*)(xb + (size_t)grow * DM + i * 256 + lane * 4) = o; }
            }
        }
    }
}

template <int K, class Epi>
DI void gemm64_res(const bf16_t* A, int lda, const bf16_t* Wp, int NU, unsigned char* lds, const Epi& epi) {
    constexpr int KS = K / 16, PD = 4, LD = K * 2 + 16, SEGS = K / 8, NIT = 64 * SEGS / NTHR;
    const int tid = otid(), wave = __builtin_amdgcn_readfirstlane(tid >> 6), lane = tid & 63, r = lane & 31, h = lane >> 5;
    const u32x4* Bw = (const u32x4*)Wp;
    const size_t kstr = (size_t)NU * NT * 64;
    __syncthreads();
#pragma unroll
    for (int i0 = 0; i0 < NIT; i0 += 8) {
        u32x4 t8[8];
#pragma unroll
        for (int i = 0; i < 8; ++i) { const int idx = (i0 + i) * NTHR + tid, row = idx / SEGS, seg = idx % SEGS; t8[i] = *(const u32x4*)(A + (row * lda + seg * 8)); }
#pragma unroll
        for (int i = 0; i < 8; ++i) { const int idx = (i0 + i) * NTHR + tid, row = idx / SEGS, seg = idx % SEGS; *(u32x4*)(lds + row * LD + seg * 16) = t8[i]; }
    }
    __syncthreads();
    const unsigned char* ab = lds + r * LD + 16 * h;
#pragma unroll 1
    for (int unit = wave; unit < NU; unit += NWAVE) {
        const u32x4* bp = Bw + (size_t)(unit * NT) * 64 + lane;
        f32x16 acc[2][NT];
#pragma unroll
        for (int mi = 0; mi < 2; ++mi)
#pragma unroll
            for (int nj = 0; nj < NT; ++nj)
#pragma unroll
                for (int i = 0; i < 16; ++i) acc[mi][nj][i] = 0.f;
        u32x4 bq[PD][NT];
#pragma unroll
        for (int s = 0; s < PD; ++s)
#pragma unroll
            for (int j = 0; j < NT; ++j) bq[s][j] = bp[(size_t)s * kstr + j * 64];
#pragma unroll 1
        for (int kk = 0; kk < KS; kk += PD) {
#pragma unroll
            for (int s = 0; s < PD; ++s) {
                const int ks = kk + s;
                const bf16x8 a0 = *(const bf16x8*)(ab + ks * 32), a1 = *(const bf16x8*)(ab + 32 * LD + ks * 32);
#pragma unroll
                for (int j = 0; j < NT; ++j) { acc[0][j] = MFMA32(a0, __builtin_bit_cast(bf16x8, bq[s][j]), acc[0][j]); acc[1][j] = MFMA32(a1, __builtin_bit_cast(bf16x8, bq[s][j]), acc[1][j]); }
                int nk = ks + PD; nk = nk < KS ? nk : KS - 1;
#pragma unroll
                for (int j = 0; j < NT; ++j) bq[s][j] = bp[(size_t)nk * kstr + j * 64];
                __builtin_amdgcn_sched_barrier(0);
            }
        }
        epi(unit, acc);
    }
}

template <int K, int MT, class Epi>
DI void gemm64(const bf16_t* A, int lda, int d2, const bf16_t* Wp, int NU, unsigned char* lds, const Epi& epi) {
    if constexpr (MT == 2 && K <= 1024) { gemm64_res<K>(A, lda, Wp, NU, lds, epi); return; }
    constexpr int KS = K / 16, NCH = K / A_CHUNK, PD = 4;
    const int tid = otid(), wave = tid >> 6, lane = tid & 63, r = lane & 31, h = lane >> 5;
    const u32x4* Bw = (const u32x4*)Wp;
#pragma unroll 1
    for (int pass = 0; pass * NWAVE < NU; ++pass) {
        const int unit = pass * NWAVE + wave;
        const bool active = unit < NU;
        const int ucl = active ? unit : NU - 1;
        const u32x4* bp = Bw + (size_t)(ucl * NT) * 64 + lane;
        const size_t kstr = (size_t)NU * NT * 64;
        f32x16 acc[MT][NT];
#pragma unroll
        for (int mi = 0; mi < MT; ++mi)
#pragma unroll
            for (int nj = 0; nj < NT; ++nj)
#pragma unroll
                for (int i = 0; i < 16; ++i) acc[mi][nj][i] = 0.f;
        u32x4 bq[PD][NT];
#pragma unroll
        for (int s = 0; s < PD; ++s)
#pragma unroll
            for (int j = 0; j < NT; ++j) bq[s][j] = bp[(size_t)s * kstr + j * 64];
        u32x4 areg[MT];
        if (pass == 0) __syncthreads();
#pragma unroll
        for (int i = 0; i < MT; ++i) { const int idx = i * NTHR + tid, row = idx >> 4, seg = idx & 15; areg[i] = *(const u32x4*)(A + ((row + (i == 2 ? d2 : 0)) * lda + seg * 8)); }
#pragma unroll
        for (int i = 0; i < MT; ++i) { const int idx = i * NTHR + tid, row = idx >> 4, seg = idx & 15; *(u32x4*)(lds + row * A_LD + seg * 16) = areg[i]; }
        lds_barrier();
#pragma unroll 1
        for (int c = 0; c < NCH; ++c) {
            if (c + 1 < NCH) {
#pragma unroll
                for (int i = 0; i < MT; ++i) { const int idx = i * NTHR + tid, row = idx >> 4, seg = idx & 15; areg[i] = *(const u32x4*)(A + ((row + (i == 2 ? d2 : 0)) * lda + (c + 1) * A_CHUNK + seg * 8)); }
            }
            const unsigned char* ab = lds + (c & 1) * A_BUF + r * A_LD + 16 * h;
            if (active) {
                bf16x8 a[MT], n[MT];
#pragma unroll
                for (int mi = 0; mi < MT; ++mi) a[mi] = *(const bf16x8*)(ab + mi * 32 * A_LD);
#pragma unroll
                for (int ks = 0; ks < A_CHUNK / 16; ++ks) {
#pragma unroll
                    for (int mi = 0; mi < MT; ++mi) n[mi] = a[mi];
                    if (ks + 1 < A_CHUNK / 16) {
#pragma unroll
                        for (int mi = 0; mi < MT; ++mi) n[mi] = *(const bf16x8*)(ab + mi * 32 * A_LD + (ks + 1) * 32);
                    }
#pragma unroll
                    for (int j = 0; j < NT; ++j)
#pragma unroll
                        for (int mi = 0; mi < MT; ++mi) acc[mi][j] = MFMA32(a[mi], __builtin_bit_cast(bf16x8, bq[ks % PD][j]), acc[mi][j]);
                    int nk = c * (A_CHUNK / 16) + ks + PD; nk = nk < KS ? nk : KS - 1;
#pragma unroll
                    for (int j = 0; j < NT; ++j) bq[ks % PD][j] = bp[(size_t)nk * kstr + j * 64];
                    __builtin_amdgcn_sched_barrier(0);
#pragma unroll
                    for (int mi = 0; mi < MT; ++mi) a[mi] = n[mi];
                }
            }
            if (c + 1 < NCH) {
                unsigned char* wb = lds + ((c + 1) & 1) * A_BUF;
#pragma unroll
                for (int i = 0; i < MT; ++i) { const int idx = i * NTHR + tid, row = idx >> 4, seg = idx & 15; *(u32x4*)(wb + row * A_LD + seg * 16) = areg[i]; }
            }
            lds_barrier();
        }
        if (active) epi(unit, acc);
    }
}

template <int MT> DI void st_bf16(bf16_t* base, int ld, int d2, int col0, const f32x16 (&acc)[MT][NT]) {
    const int lane = otid() & 63, r = lane & 31, h = lane >> 5;
#pragma unroll
    for (int mi = 0; mi < MT; ++mi)
#pragma unroll
        for (int nj = 0; nj < NT; ++nj)
#pragma unroll
            for (int i = 0; i < 16; ++i) base[(mi * 32 + crow(i, h) + (mi == 2 ? d2 : 0)) * ld + col0 + nj * 32 + r] = cv1(acc[mi][nj][i]);
}
template <int MI0, int MI1, int MT> DI void st_f32(float* base, int ld, int col0, const f32x16 (&acc)[MT][NT]) {
    const int lane = otid() & 63, r = lane & 31, h = lane >> 5;
#pragma unroll
    for (int mi = MI0; mi < MI1; ++mi)
#pragma unroll
        for (int nj = 0; nj < NT; ++nj)
#pragma unroll
            for (int i = 0; i < 16; ++i) base[((mi - MI0) * 32 + crow(i, h)) * ld + col0 + nj * 32 + r] = acc[mi][nj][i];
}
template <int MT> DI void st_kp(bf16_t* kp, int H, int KSQ, int hd, int dbase, int tb0, int tb2, const f32x16 (&acc)[MT][NT]) {
    const int lane = otid() & 63, r = lane & 31, h = lane >> 5;
#pragma unroll
    for (int mi = 0; mi < MT; ++mi)
#pragma unroll
        for (int nj = 0; nj < NT; ++nj) {
            const int tb = mi == 2 ? tb2 : tb0 + mi, d = dbase + nj * 32 + r;
            bf16_t* fp = kp + ((tb * H + hd) * KSQ + (d >> 4)) * 512 + 32 * ((d >> 3) & 1) * 8 + (d & 7);
#pragma unroll
            for (int i = 0; i < 16; ++i) fp[crow(i, h) * 8] = cv1(acc[mi][nj][i]);
        }
}
template <int MT> DI void st_vp(bf16_t* vp, int DTt, int dd0, int tb0, int tb2, const f32x16 (&acc)[MT][NT]) {
    const int lane = otid() & 63;
#pragma unroll
    for (int mi = 0; mi < MT; ++mi)
#pragma unroll
        for (int nj = 0; nj < NT; ++nj)
#pragma unroll
            for (int sp_ = 0; sp_ < 2; ++sp_) {
                const int tb = mi == 2 ? tb2 : tb0 + mi;
                u32x4 w = {pk2(acc[mi][nj][8 * sp_], acc[mi][nj][8 * sp_ + 1]), pk2(acc[mi][nj][8 * sp_ + 2], acc[mi][nj][8 * sp_ + 3]),
                           pk2(acc[mi][nj][8 * sp_ + 4], acc[mi][nj][8 * sp_ + 5]), pk2(acc[mi][nj][8 * sp_ + 6], acc[mi][nj][8 * sp_ + 7])};
                *(u32x4*)(vp + ((((tb * DTt + dd0 + nj) * 2 + sp_) * 64 + lane) * 8)) = w;
            }
}

template <int MT> struct EpiMixIn {
    bf16_t* priv; bf16_t *ka, *kb, *vta, *vtb; int d2, tb0, tb2;
    float *oak, *oav, *obk, *obv;
    float *sak, *sav, *sbk, *sbv;
    DI void operator()(int unit, const f32x16 (&acc)[MT][NT]) const {
        if (unit < 8) st_bf16<MT>(priv, PRIVW, d2, PC_QA + unit * UW, acc);
        else if (unit < 10) { st_kp<MT>(ka, 2, 4, unit - 8, 0, tb0, tb2, acc); if (oak) st_f32<0, 2, MT>(oak, 128, (unit - 8) * UW, acc); if (MT == 3) st_f32<2, MT, MT>(sak, 128, (unit - 8) * UW, acc); }
        else if (unit < 12) { st_vp<MT>(vta, 4, (unit - 10) * 2, tb0, tb2, acc); if (oav) st_f32<0, 2, MT>(oav, 128, (unit - 10) * UW, acc); if (MT == 3) st_f32<2, MT, MT>(sav, 128, (unit - 10) * UW, acc); }
        else if (unit < 20) st_bf16<MT>(priv, PRIVW, d2, PC_QB + (unit - 12) * UW, acc);
        else if (unit < 28) { st_kp<MT>(kb, 8, 4, unit - 20, 0, tb0, tb2, acc); if (obk) st_f32<0, 2, MT>(obk, 512, (unit - 20) * UW, acc); if (MT == 3) st_f32<2, MT, MT>(sbk, 512, (unit - 20) * UW, acc); }
        else if (unit < 36) { st_vp<MT>(vtb, 16, (unit - 28) * 2, tb0, tb2, acc); if (obv) st_f32<0, 2, MT>(obv, 512, (unit - 28) * UW, acc); if (MT == 3) st_f32<2, MT, MT>(sbv, 512, (unit - 28) * UW, acc); }
        else {
            const int lane = otid() & 63, r = lane & 31, h = lane >> 5;
            const int col0 = PC_GA + (unit - 36) * UW;
#pragma unroll
            for (int mi = 0; mi < MT; ++mi)
#pragma unroll
                for (int nj = 0; nj < NT; ++nj)
#pragma unroll
                    for (int i = 0; i < 16; ++i) priv[(mi * 32 + crow(i, h) + (mi == 2 ? d2 : 0)) * PRIVW + col0 + nj * 32 + r] = cv1(sigm(acc[mi][nj][i]));
        }
    }
};
template <int MT, int SECOND> struct EpiGate {
    bf16_t* priv; int gcol; int d2;
    DI void operator()(int unit, const f32x16 (&acc)[MT][NT]) const {
        const int lane = otid() & 63, r = lane & 31, h = lane >> 5;
#pragma unroll
        for (int mi = 0; mi < MT; ++mi)
#pragma unroll
            for (int nj = 0; nj < NT; ++nj)
#pragma unroll
                for (int i = 0; i < 16; ++i) {
                    bf16_t* rowp = priv + (mi * 32 + crow(i, h) + (mi == 2 ? d2 : 0)) * PRIVW; const int c = unit * UW + nj * 32 + r;
                    float v = bf2f(rowp[gcol + c]) * acc[mi][nj][i];
                    if (SECOND) v += bf2f(rowp[PC_M + c]);
                    rowp[PC_M + c] = cv1(v);
                    if (i == 15) __builtin_amdgcn_sched_barrier(0);
                }
    }
};
template <int MT> struct EpiResid {
    float* x; int d2;
    DI void operator()(int unit, const f32x16 (&acc)[MT][NT]) const {
        const int lane = otid() & 63, r = lane & 31, h = lane >> 5;
#pragma unroll
        for (int mi = 0; mi < MT; ++mi)
#pragma unroll
            for (int nj = 0; nj < NT; ++nj)
#pragma unroll
                for (int i = 0; i < 16; ++i) { float* q = x + ((mi * 32 + crow(i, h) + (mi == 2 ? d2 : 0)) * DM + unit * UW + nj * 32 + r); *q = *q + acc[mi][nj][i]; if (i == 15) __builtin_amdgcn_sched_barrier(0); }
    }
};
template <int MT> struct EpiStore { bf16_t* base; int ld; int col0; int d2;
    DI void operator()(int unit, const f32x16 (&acc)[MT][NT]) const { st_bf16<MT>(base, ld, d2, col0 + unit * UW, acc); } };
template <int MT> struct EpiUp {
    bf16_t* priv; float* halo; float* pconv; float* sconv; int d2;
    DI void operator()(int unit, const f32x16 (&acc)[MT][NT]) const {
        st_bf16<MT>(priv, PRIVW, d2, unit * UW, acc);
        const int lane = otid() & 63, r = lane & 31, h = lane >> 5;
#pragma unroll
        for (int mi = 1; mi < MT; ++mi)
#pragma unroll
            for (int nj = 0; nj < NT; ++nj)
#pragma unroll
                for (int i = 0; i < 16; ++i) {
                    const int lr = mi * 32 + crow(i, h), c = unit * UW + nj * 32 + r;
                    if (mi == 1) { if (lr >= 62) { halo[(lr - 62) * DFF2 + c] = acc[mi][nj][i]; if (pconv) pconv[(lr - 62) * DFF2 + c] = acc[mi][nj][i]; } }
                    else if ((lr & 15) >= 14) sconv[(((lr - 64) >> 4) * 2 + ((lr & 15) - 14)) * DFF2 + c] = acc[mi][nj][i];
                }
    }
};
struct EpiMemKV { bf16_t* kp; bf16_t* vp; float* o; int isv; int tb0;
    DI void operator()(int unit, const f32x16 (&acc)[2][NT]) const {
        if (isv) st_vp<2>(vp, 16, unit * 2, tb0, 0, acc); else st_kp<2>(kp, 4, 8, unit >> 1, (unit & 1) * 64, tb0, 0, acc);
        st_f32<0, 2, 2>(o, 512, unit * UW, acc);
    } };

template <int HD, int BIAS, bool FULL>
DI void attn_block(const bf16_t* Kb, int ktb, const bf16_t* Vb, int vtb, int koff, int kpos0, int qp, float slope, const float* rel,
                   const bf16x8 (&qf)[HD / 16], f32x16 (&o)[HD / 32], float& m, float& l) {
    constexpr int KSQ = HD / 16, DT = HD / 32, NKT = FULL ? 2 : 1;
    constexpr bool VTOP = HD == 64;
    const int lane = otid() & 63, h = lane >> 5;
    const int kbeg = FULL ? 0 : koff, kend = FULL ? 64 : koff + 16;
    const int s0 = FULL ? 0 : (koff >> 4);
    int dq = kpos0 + 4 * h - qp; asm volatile("" : "+v"(dq));
    bf16x8 kreg[NKT][KSQ];
#pragma unroll
    for (int kt = 0; kt < NKT; ++kt)
#pragma unroll
        for (int ks = 0; ks < KSQ; ++ks) kreg[kt][ks] = *(const bf16x8*)(Kb + (size_t)kt * ktb + ks * 512 + lane * 8);
    constexpr int NS = FULL ? 4 : 1;
    bf16x8 vreg[DT][NS];
    auto loadV = [&]() {
#pragma unroll
        for (int si = 0; si < NS; ++si)
#pragma unroll
            for (int dt = 0; dt < DT; ++dt) { const int s = FULL ? si : s0; vreg[dt][si] = *(const bf16x8*)(Vb + (size_t)(s >> 1) * vtb + dt * 1024 + (s & 1) * 512 + lane * 8); }
    };
    if (VTOP) loadV();
    __builtin_amdgcn_sched_barrier(0);
    f32x16 st[NKT];
#pragma unroll
    for (int kt = 0; kt < NKT; ++kt) {
#pragma unroll
        for (int i = 0; i < 16; ++i) st[kt][i] = 0.f;
#pragma unroll
        for (int ks = 0; ks < KSQ; ++ks) st[kt] = MFMA32(kreg[kt][ks], qf[ks], st[kt]);
    }
    __builtin_amdgcn_sched_barrier(0);
    if (!VTOP) loadV();
    float mx = -1e30f;
#pragma unroll
    for (int kt = 0; kt < NKT; ++kt)
#pragma unroll
        for (int i = 0; i < 16; ++i) {
            const int key = kt * 32 + crow(i, h);
            float s = st[kt][i];
            const int dk = dq + (kt * 32 + (i & 3) + 8 * (i >> 2));
            if (BIAS == 1) s -= slope * (float)(dk < 0 ? -dk : dk);
            if (BIAS == 2) { int d = dk < -256 ? -256 : (dk > 256 ? 256 : dk); s += rel[d + 256]; }
            if (!FULL) { if (key < kbeg || key >= kend) s = -1e30f; }
            st[kt][i] = s; mx = fmaxf(mx, s);
        }
    mx = fmaxf(mx, __shfl_xor(mx, 32));
    const float mn = fmaxf(m, mx);
    const float alpha = __builtin_amdgcn_exp2f((m - mn) * LOG2E);
    m = mn;
    float ps = 0.f;
#pragma unroll
    for (int kt = 0; kt < NKT; ++kt)
#pragma unroll
        for (int i = 0; i < 16; ++i) { const float pv = __builtin_amdgcn_exp2f((st[kt][i] - mn) * LOG2E); st[kt][i] = pv; ps += pv; }
    l = l * alpha + ps;
#pragma unroll
    for (int dt = 0; dt < DT; ++dt)
#pragma unroll
        for (int i = 0; i < 16; ++i) o[dt][i] *= alpha;
#pragma unroll
    for (int si = 0; si < NS; ++si) {
        u32x4 pw;
        if (FULL) { const int kt = si >> 1, b0 = (si & 1) * 8; pw = (u32x4){pk2(st[kt][b0], st[kt][b0 + 1]), pk2(st[kt][b0 + 2], st[kt][b0 + 3]), pk2(st[kt][b0 + 4], st[kt][b0 + 5]), pk2(st[kt][b0 + 6], st[kt][b0 + 7])}; }
        else {
            const u32x4 lo = {pk2(st[0][0], st[0][1]), pk2(st[0][2], st[0][3]), pk2(st[0][4], st[0][5]), pk2(st[0][6], st[0][7])};
            const u32x4 hi = {pk2(st[0][8], st[0][9]), pk2(st[0][10], st[0][11]), pk2(st[0][12], st[0][13]), pk2(st[0][14], st[0][15])};
            pw = (s0 & 1) ? hi : lo;
        }
        const bf16x8 pf = __builtin_bit_cast(bf16x8, pw);
#pragma unroll
        for (int dt = 0; dt < DT; ++dt) o[dt] = MFMA32(vreg[dt][si], pf, o[dt]);
    }
}

template <int HD, int BIAS>
DI void attn_item(const bf16_t* Q, int qstride, int nq, int qpos0,
                  const bf16_t* K1, int ktb1, const bf16_t* V1, int vtb1, int nb1, int pos1,
                  const bf16_t* K2, const bf16_t* V2, int nb2, int pos2, int koff2,
                  float m0, float l0, float slope, const float* rel, bf16_t* O, int ostride) {
    constexpr int KSQ = HD / 16, DT = HD / 32;
    const int lane = otid() & 63, r = lane & 31, h = lane >> 5;
    const int qr = r < nq ? r : nq - 1;
    bf16x8 qf[KSQ];
#pragma unroll
    for (int ks = 0; ks < KSQ; ++ks) qf[ks] = *(const bf16x8*)(Q + (size_t)qr * qstride + ks * 16 + 8 * h);
    f32x16 o[DT];
#pragma unroll
    for (int dt = 0; dt < DT; ++dt)
#pragma unroll
        for (int i = 0; i < 16; ++i) o[dt][i] = 0.f;
    float m = m0, l = h == 0 ? l0 : 0.f;
    const int qp = qpos0 + qr;
#pragma unroll 1
    for (int blk = 0; blk < nb1; ++blk)
        attn_block<HD, BIAS, true>(K1 + (size_t)(2 * blk) * ktb1, ktb1, V1 + (size_t)(2 * blk) * vtb1, vtb1, 0, pos1 + blk * 64, qp, slope, rel, qf, o, m, l);
    if (nb2) attn_block<HD, BIAS, false>(K2, 0, V2, 0, koff2, pos2 - koff2, qp, slope, rel, qf, o, m, l);
    const float lt = l + __shfl_xor(l, 32);
    const float inv = 1.f / lt;
    if (r < nq) {
#pragma unroll
        for (int dt = 0; dt < DT; ++dt)
#pragma unroll
            for (int g = 0; g < 4; ++g) {
                u32x2 w = {pk2(o[dt][4 * g] * inv, o[dt][4 * g + 1] * inv), pk2(o[dt][4 * g + 2] * inv, o[dt][4 * g + 3] * inv)};
                *(u32x2*)(O + (size_t)r * ostride + dt * 32 + 8 * g + 4 * h) = w;
            }
    }
}

DI const bf16_t* wp(const Params& p, int l, size_t off) { return (const bf16_t*)(p.ws + OFF_WP) + (size_t)l * PW_LAYER + off; }
DI int tile_d2(int t) { return SEQ + 32 * t - (64 * t + 64); }

template <int MT> DI void phaseA(const Params& p, int l, int t, unsigned char* lds) {
    const int row0 = t * 64, d2 = MT == 3 ? tile_d2(t) : 0;
    unsigned char* ws = p.ws;
    EpiMixIn<MT> e;
    e.priv = (bf16_t*)(ws + OFF_PRIV) + (size_t)row0 * PRIVW;
    e.ka = (bf16_t*)(ws + OFF_KA); e.kb = (bf16_t*)(ws + OFF_KB); e.vta = (bf16_t*)(ws + OFF_VTA); e.vtb = (bf16_t*)(ws + OFF_VTB);
    e.tb0 = 2 * t; e.tb2 = SEQ / 32 + t;
    e.d2 = d2;
    e.oak = e.oav = e.obk = e.obv = nullptr;
    e.sak = e.sav = e.sbk = e.sbv = nullptr;
    if (row0 >= SEQ - 128) { const int pr = row0 - (SEQ - 128); e.oak = p.out + O_PAK + (size_t)l * 128 * 128 + (size_t)pr * 128; e.oav = p.out + O_PAV + (size_t)l * 128 * 128 + (size_t)pr * 128; }
    if (row0 >= SEQ - 512) { const int pr = row0 - (SEQ - 512); e.obk = p.out + O_PBK + (size_t)l * 512 * 512 + (size_t)pr * 512; e.obv = p.out + O_PBV + (size_t)l * 512 * 512 + (size_t)pr * 512; }
    if (MT == 3) {
        const int sr = 32 * t;
        e.sak = p.out + O_SAK + (size_t)l * 128 * 128 + (size_t)sr * 128; e.sav = p.out + O_SAV + (size_t)l * 128 * 128 + (size_t)sr * 128;
        e.sbk = p.out + O_SBK + (size_t)l * 128 * 512 + (size_t)sr * 512; e.sbv = p.out + O_SBV + (size_t)l * 128 * 512 + (size_t)sr * 512;
    }
    gemm64<1024, MT>((const bf16_t*)(ws + OFF_XB) + (size_t)row0 * DM, DM, d2, wp(p, l, PW_IN), DIN / UW, lds, e);
}

DI void mem_kv_unit(const Params& p, int e, unsigned char* lds) {
    const int l = e >> 3, kv = (e >> 2) & 1, rt = e & 3;
    unsigned char* ws = p.ws;
    EpiMemKV ep;
    ep.kp = (bf16_t*)(ws + OFF_MK) + (size_t)l * 256 * 512;
    ep.vp = (bf16_t*)(ws + OFF_MVT) + (size_t)l * 256 * 512;
    ep.tb0 = rt * 2;
    ep.o = p.out + (kv ? O_PMV : O_PMK) + (size_t)l * 256 * 512 + (size_t)rt * 64 * 512;
    ep.isv = kv;
    gemm64<1024, 2>((const bf16_t*)(ws + OFF_MEMB) + (size_t)rt * 64 * DM, DM, 0, (const bf16_t*)(ws + OFF_UHALO) + (size_t)(l * 2 + kv) * 512 * 1024, 512 / UW, lds, ep);
}

template <int MT> DI void phaseB(const Params& p, int l, int t, unsigned char* lds) {
    const int row0 = t * 64, d2 = MT == 3 ? tile_d2(t) : 0, tid = otid(), wave = __builtin_amdgcn_readfirstlane(tid >> 6);
    unsigned char* ws = p.ws;
    bf16_t* priv = (bf16_t*)(ws + OFF_PRIV) + (size_t)row0 * PRIVW;
    bf16_t* xb = (bf16_t*)(ws + OFF_XB) + (size_t)row0 * DM;
    float* x = p.out + (size_t)row0 * DM;
    const bf16_t* KA = (const bf16_t*)(ws + OFF_KA); const bf16_t* VTA = (const bf16_t*)(ws + OFF_VTA);
    const bf16_t* KB = (const bf16_t*)(ws + OFF_KB); const bf16_t* VTB = (const bf16_t*)(ws + OFF_VTB);
    float* rel = (float*)lds;
    __syncthreads();
    for (int i = tid; i < 8 * 513; i += NTHR) rel[i] = p.in[13][(size_t)l * 8 * 513 + i];
    __syncthreads();
    const float* sink = p.in[12] + l * 8;
    for (int it = wave; it < (MT == 3 ? 64 : 32); it += NWAVE) {
        if (it < 32) {
            const int c = t, isB = it >> 4, hq = (it >> 1) & 7, qh = it & 1;
            if (!isB) {
                const int kvh = hq >> 2, c0 = c - 2 < 0 ? 0 : c - 2;
                attn_item<64, 1>(priv + (size_t)(32 * qh) * PRIVW + PC_QA + hq * 64, PRIVW, 32, row0 + 32 * qh,
                                 KA + (size_t)(2 * c0) * 4096 + kvh * 2048, 4096, VTA + (size_t)(2 * c0) * 4096 + kvh * 2048, 4096, c - c0 + 1, 64 * c0,
                                 nullptr, nullptr, 0, 0, 0,
                                 sink[hq], 1.f, exp2f(-(float)(hq + 1)), nullptr, priv + (size_t)(32 * qh) * PRIVW + PC_OA + hq * 64, PRIVW);
            } else {
                const int c0 = c - 8 < 0 ? 0 : c - 8;
                attn_item<64, 2>(priv + (size_t)(32 * qh) * PRIVW + PC_QB + hq * 64, PRIVW, 32, row0 + 32 * qh,
                                 KB + (size_t)(2 * c0) * 16384 + hq * 2048, 16384, VTB + (size_t)(2 * c0) * 16384 + hq * 2048, 16384, c - c0 + 1, 64 * c0,
                                 nullptr, nullptr, 0, 0, 0,
                                 -1e30f, 0.f, 0.f, rel + hq * 513, priv + (size_t)(32 * qh) * PRIVW + PC_OB + hq * 64, PRIVW);
            }
        } else {
            const int j = it - 32, isB = j >> 4, bb = (j >> 3) & 1, hq = j & 7, b = 2 * t + bb;
            const size_t nrow = (size_t)SEQ + b * 16;
            const int tbn = SEQ / 32 + t, koff = bb * 16;
            bf16_t* sp = (bf16_t*)(ws + OFF_PRIV) + nrow * PRIVW;
            if (!isB) {
                const int kvh = hq >> 2;
                attn_item<64, 1>(sp + PC_QA + hq * 64, PRIVW, 16, 1024,
                                 (const bf16_t*)(ws + OFF_SKA) + (size_t)b * 16384 + kvh * 2048, 4096, (const bf16_t*)(ws + OFF_SVTA) + (size_t)b * 16384 + kvh * 2048, 4096, 2, 896,
                                 KA + (size_t)tbn * 4096 + kvh * 2048, VTA + (size_t)tbn * 4096 + kvh * 2048, 1, 1024, koff,
                                 sink[hq], 1.f, exp2f(-(float)(hq + 1)), nullptr, sp + PC_OA + hq * 64, PRIVW);
            } else {
                attn_item<64, 2>(sp + PC_QB + hq * 64, PRIVW, 16, 1024,
                                 (const bf16_t*)(ws + OFF_SKB) + (size_t)b * 262144 + hq * 2048, 16384, (const bf16_t*)(ws + OFF_SVTB) + (size_t)b * 262144 + hq * 2048, 16384, 8, 512,
                                 KB + (size_t)tbn * 16384 + hq * 2048, VTB + (size_t)tbn * 16384 + hq * 2048, 1, 1024, koff,
                                 -1e30f, 0.f, 0.f, rel + hq * 513, sp + PC_OB + hq * 64, PRIVW);
            }
        }
    }
    gemm64<512, MT>(priv + PC_OA, PRIVW, d2, wp(p, l, PW_OA), DM / UW, lds, EpiGate<MT, 0>{priv, PC_GA, d2});
    gemm64<512, MT>(priv + PC_OB, PRIVW, d2, wp(p, l, PW_OB), DM / UW, lds, EpiGate<MT, 1>{priv, PC_GB, d2});
    gemm64<1024, MT>(priv + PC_M, PRIVW, d2, wp(p, l, PW_OUT), DM / UW, lds, EpiResid<MT>{x, d2});
    __syncthreads();
    norm_rows<1, MT>(nullptr, nullptr, x, d2, xb, nullptr);
    gemm64<1024, MT>(xb, DM, d2, wp(p, l, PW_XQ), 512 / UW, lds, EpiStore<MT>{priv, PRIVW, PC_QX, d2});
    __syncthreads();
    for (int it = wave; it < (MT == 3 ? 16 : 8); it += NWAVE) {
        if (it < 8) {
            const int hx = it >> 1, qh = it & 1;
            attn_item<128, 0>(priv + (size_t)(32 * qh) * PRIVW + PC_QX + hx * 128, PRIVW, 32, 0,
                              (const bf16_t*)(ws + OFF_MK) + (size_t)l * 131072 + hx * 4096, 16384, (const bf16_t*)(ws + OFF_MVT) + (size_t)l * 131072 + hx * 4096, 16384, 4, 0,
                              nullptr, nullptr, 0, 0, 0,
                              -1e30f, 0.f, 0.f, nullptr, priv + (size_t)(32 * qh) * PRIVW + PC_OX + hx * 128, PRIVW);
        } else {
            const int j = it - 8, bb = j >> 2, hx = j & 3, b = 2 * t + bb;
            bf16_t* sp = (bf16_t*)(ws + OFF_PRIV) + ((size_t)SEQ + b * 16) * PRIVW;
            attn_item<128, 0>(sp + PC_QX + hx * 128, PRIVW, 16, 0,
                              (const bf16_t*)(ws + OFF_SMK) + (size_t)b * 131072 + hx * 4096, 16384, (const bf16_t*)(ws + OFF_SMVT) + (size_t)b * 131072 + hx * 4096, 16384, 4, 0,
                              nullptr, nullptr, 0, 0, 0,
                              -1e30f, 0.f, 0.f, nullptr, sp + PC_OX + hx * 128, PRIVW);
        }
    }
    gemm64<512, MT>(priv + PC_OX, PRIVW, d2, wp(p, l, PW_XO), DM / UW, lds, EpiResid<MT>{x, d2});
    __syncthreads();
    norm_rows<1, MT>(nullptr, nullptr, x, d2, xb, nullptr);
    EpiUp<MT> eu; eu.priv = priv; eu.d2 = d2;
    eu.halo = (float*)(ws + OFF_UHALO) + (size_t)t * 2 * DFF2;
    eu.pconv = t == NTILE - 1 ? p.out + O_PCONV + (size_t)l * 2 * DFF2 : nullptr;
    eu.sconv = p.out + O_SCONV + ((size_t)l * 8 + 2 * t) * 2 * DFF2;
    gemm64<1024, MT>(xb, DM, d2, wp(p, l, PW_UP), DFF2 / UW, lds, eu);
}

template <int NR> DI void conv_seg(bf16_t* rows, const float* st, const float (&wg)[3][2], const float (&wu)[3][2], const float (&bg)[2], const float (&bu)[2], int j) {
    float g2[2] = {0.f, 0.f}, g1[2] = {0.f, 0.f}, u2[2] = {0.f, 0.f}, u1[2] = {0.f, 0.f};
    if (st) {
        g2[0] = st[j]; g2[1] = st[j + 1]; u2[0] = st[DFF + j]; u2[1] = st[DFF + j + 1];
        g1[0] = st[DFF2 + j]; g1[1] = st[DFF2 + j + 1]; u1[0] = st[DFF2 + DFF + j]; u1[1] = st[DFF2 + DFF + j + 1];
    }
    for (int lb = 0; lb < NR; lb += 8) {
        unsigned gwv[8], uwv[8];
#pragma unroll
        for (int q8 = 0; q8 < 8; ++q8) { const bf16_t* rp = rows + (size_t)(lb + q8) * PRIVW; gwv[q8] = *(const unsigned*)(rp + j); uwv[q8] = *(const unsigned*)(rp + DFF + j); }
#pragma unroll
        for (int q8 = 0; q8 < 8; ++q8) {
            const unsigned gw = gwv[q8], uw = uwv[q8];
            const float g0[2] = {bf2f((bf16_t)(gw & 0xffffu)), bf2f((bf16_t)(gw >> 16))};
            const float u0[2] = {bf2f((bf16_t)(uw & 0xffffu)), bf2f((bf16_t)(uw >> 16))};
            float a[2];
#pragma unroll
            for (int q = 0; q < 2; ++q) {
                const float cg_ = bg[q] + wg[0][q] * g2[q] + wg[1][q] * g1[q] + wg[2][q] * g0[q];
                const float cu_ = bu[q] + wu[0][q] * u2[q] + wu[1][q] * u1[q] + wu[2][q] * u0[q];
                a[q] = cg_ * sigm(cg_) * cu_;
                g2[q] = g1[q]; g1[q] = g0[q]; u2[q] = u1[q]; u1[q] = u0[q];
            }
            *(unsigned*)(rows + (size_t)(lb + q8) * PRIVW + j) = pk2(a[0], a[1]);
        }
    }
}

template <int MT> DI void phaseC(const Params& p, int l, int t, unsigned char* lds) {
    const int row0 = t * 64, d2 = MT == 3 ? tile_d2(t) : 0, tid = otid();
    unsigned char* ws = p.ws;
    bf16_t* priv = (bf16_t*)(ws + OFF_PRIV) + (size_t)row0 * PRIVW;
    bf16_t* xb = (bf16_t*)(ws + OFF_XB) + (size_t)row0 * DM;
    float* x = p.out + (size_t)row0 * DM;
    const float* wc = p.in[25] + (size_t)l * 3 * DFF2;
    const float* bc = p.in[26] + (size_t)l * DFF2;
    __syncthreads();
    for (int jp = tid; jp < DFF / 2; jp += NTHR) {
        const int j = jp * 2;
        float wg[3][2], wu[3][2], bg[2], bu[2];
#pragma unroll
        for (int k = 0; k < 3; ++k) { wg[k][0] = wc[k * DFF2 + j]; wg[k][1] = wc[k * DFF2 + j + 1]; wu[k][0] = wc[k * DFF2 + DFF + j]; wu[k][1] = wc[k * DFF2 + DFF + j + 1]; }
        bg[0] = bc[j]; bg[1] = bc[j + 1]; bu[0] = bc[DFF + j]; bu[1] = bc[DFF + j + 1];
        conv_seg<64>(priv, t > 0 ? (const float*)(ws + OFF_UHALO) + (size_t)(t - 1) * 2 * DFF2 : nullptr, wg, wu, bg, bu, j);
        if (MT == 3) {
            conv_seg<16>(priv + (size_t)(64 + d2) * PRIVW, p.in[9] + ((size_t)l * 8 + 2 * t) * 2 * DFF2, wg, wu, bg, bu, j);
            conv_seg<16>(priv + (size_t)(80 + d2) * PRIVW, p.in[9] + ((size_t)l * 8 + 2 * t + 1) * 2 * DFF2, wg, wu, bg, bu, j);
        }
    }
    gemm64<DFF, MT>(priv, PRIVW, d2, wp(p, l, PW_DOWN), DM / UW, lds, EpiResid<MT>{x, d2});
    __syncthreads();
    if (l == DEPTH - 1) norm_rows<2, MT>(nullptr, nullptr, x, d2, nullptr, p.in[28]);
    else norm_rows<1, MT>(nullptr, nullptr, x, d2, xb, nullptr);
}

DI void pack_layer(const Params& p, int l, int gtid_, int gthreads) {
    int gtid = gtid_; asm volatile("" : "+v"(gtid));
    bf16_t* w = (bf16_t*)(p.ws + OFF_WP) + (size_t)l * PW_LAYER;
    pack_w(p.in[11] + (size_t)l * DM * DIN, p.in[10] + l * DM, DM, DIN, w + PW_IN, 1, gtid, gthreads);
    pack_w(p.in[14] + (size_t)l * 512 * DM, nullptr, 512, DM, w + PW_OA, 0, gtid, gthreads);
    pack_w(p.in[15] + (size_t)l * 512 * DM, nullptr, 512, DM, w + PW_OB, 0, gtid, gthreads);
    pack_w(p.in[16] + (size_t)l * DM * DM, nullptr, DM, DM, w + PW_OUT, 0, gtid, gthreads);
    pack_w(p.in[19] + (size_t)l * DM * 512, p.in[17] + l * DM, DM, 512, w + PW_XQ, 2, gtid, gthreads);
    pack_w(p.in[22] + (size_t)l * 512 * DM, nullptr, 512, DM, w + PW_XO, 0, gtid, gthreads);
    pack_w(p.in[24] + (size_t)l * DM * DFF2, p.in[23] + l * DM, DM, DFF2, w + PW_UP, 0, gtid, gthreads);
    pack_w(p.in[27] + (size_t)l * DFF * DM, nullptr, DFF, DM, w + PW_DOWN, 0, gtid, gthreads);
}

#define XB_TMO      128
#define XB_XCNT(j)  (256  + 64 * (j))
#define XB_XSUB(j)  (1280 + 64 * (j))
#define XB_XGEN(j)  (2304 + 64 * (j))
#define XB_TOP      3328
#define XB_TOPGEN   3392
#define XCD_BAR_WORDS 3456
#define XB_SPIN_CAP (1u << 18)
#define LAS __attribute__((address_space(3)))

__device__ __forceinline__ unsigned xb_ld(unsigned* p)              { return __hip_atomic_load(p, __ATOMIC_RELAXED, __HIP_MEMORY_SCOPE_AGENT); }
__device__ __forceinline__ unsigned xb_add(unsigned* p, unsigned v) { return __hip_atomic_fetch_add(p, v, __ATOMIC_RELAXED, __HIP_MEMORY_SCOPE_AGENT); }
__device__ __forceinline__ unsigned xb_xcc_id() { return (unsigned)__builtin_amdgcn_s_getreg((3 << 11) | 20) & 0xFu; }
#define XB_SPIN(cond, bar) do { unsigned _sp = 0; while (cond) { __builtin_amdgcn_s_sleep(1); \
    if ((++_sp & 255u) == 0u) { if (xb_ld(&(bar)[XB_TMO])) break; if (_sp > XB_SPIN_CAP) { atomicAdd(&(bar)[XB_TMO], 1u); break; } } } } while (0)

struct XcdBarrier {
    unsigned* bar; unsigned x;
    volatile LAS unsigned* st;
};

__device__ __forceinline__ XcdBarrier xcd_barrier_post(unsigned* bar, volatile LAS unsigned* st) {
    XcdBarrier b; b.bar = bar; b.x = xb_xcc_id(); b.st = st;
    if (threadIdx.x == 0) (void)xb_add(&bar[XB_XCNT(b.x)], 1u);
    return b;
}
__device__ __forceinline__ void xcd_barrier_complete(unsigned* bar, unsigned x, unsigned& nloc, unsigned& nx) {
    const unsigned G = gridDim.x * gridDim.y * gridDim.z;
    unsigned sum, cnt, mine, sp = 0u;
    for (;;) {
        sum = 0u; cnt = 0u; mine = 0u;
#pragma unroll
        for (unsigned j = 0; j < 16; ++j) { const unsigned c = xb_ld(&bar[XB_XCNT(j)]); sum += c; cnt += (c > 0u) ? 1u : 0u; mine = (j == x) ? c : mine; }
        if (sum == G) break;
        __builtin_amdgcn_s_sleep(1);
        if ((++sp & 255u) == 0u) { if (xb_ld(&bar[XB_TMO])) break; if (sp > XB_SPIN_CAP) { atomicAdd(&bar[XB_TMO], 1u); break; } }
    }
    nloc = mine > 0u ? mine : 1u; nx = cnt > 0u ? cnt : 1u;
}

__device__ __forceinline__ void xcd_barrier(const XcdBarrier& b) {
    asm volatile("s_waitcnt vmcnt(0)" ::: "memory");
    __syncthreads();
    if (threadIdx.x == 0) {
        unsigned* bar = b.bar;
        __builtin_amdgcn_s_waitcnt(0);
        unsigned nloc = b.st[0], nx = b.st[1];
        if (nloc == 0u) { xcd_barrier_complete(bar, b.x, nloc, nx); b.st[0] = nloc; b.st[1] = nx; }
        const unsigned old = xb_add(&bar[XB_XSUB(b.x)], 1u);
        const unsigned gen = old / nloc;
        if (old + 1u == (gen + 1u) * nloc) {
            __builtin_amdgcn_fence(__ATOMIC_RELEASE, "agent");
            asm volatile("s_waitcnt vmcnt(0)" ::: "memory");
            const unsigned og = xb_add(&bar[XB_TOP], 1u);
            const unsigned tg = og / nx;
            if (og + 1u == (tg + 1u) * nx) xb_add(&bar[XB_TOPGEN], 1u);
            else XB_SPIN(xb_ld(&bar[XB_TOPGEN]) == tg, bar);
            __builtin_amdgcn_fence(__ATOMIC_ACQUIRE, "agent");
            xb_add(&bar[XB_XGEN(b.x)], 1u);
            asm volatile("s_waitcnt vmcnt(0)" ::: "memory");
        } else {
            XB_SPIN(xb_ld(&bar[XB_XGEN(b.x)]) == gen, bar);
            __builtin_amdgcn_fence(__ATOMIC_ACQUIRE, "agent");
            asm volatile("s_waitcnt vmcnt(0)" ::: "memory");
        }
    }
    __syncthreads();
}


__global__ void __launch_bounds__(NTHR) mega(Params p) {
    cg::grid_group grid = cg::this_grid();
    __shared__ __attribute__((aligned(16))) unsigned char lds[LDS_BYTES];
    __shared__ uint4 xb_words;
    if (threadIdx.x == 0) xb_words = make_uint4(0u, 0u, 0u, 0u);
    __syncthreads();
    (void)xcd_barrier_post((unsigned*)(p.ws + OFF_BAR), (volatile LAS unsigned*)&xb_words);
    auto xsync = [&]() { XcdBarrier b; b.bar = (unsigned*)(p.ws + OFF_BAR); b.x = xb_xcc_id(); b.st = (volatile LAS unsigned*)&xb_words; xcd_barrier(b); };
    const int G = gridDim.x, bid = blockIdx.x, tid = threadIdx.x;
    const int gtid = bid * NTHR + tid, gthreads = G * NTHR;
    unsigned char* ws = p.ws;
    pack_layer(p, 0, gtid, gthreads);
    for (int l = 0; l < DEPTH; ++l) {
        pack_w(p.in[20] + (size_t)l * DM * 512, p.in[18] + l * DM, DM, 512, (bf16_t*)(ws + OFF_UHALO) + (size_t)(l * 2 + 0) * 512 * 1024, 0, gtid, gthreads);
        pack_w(p.in[21] + (size_t)l * DM * 512, p.in[18] + l * DM, DM, 512, (bf16_t*)(ws + OFF_UHALO) + (size_t)(l * 2 + 1) * 512 * 1024, 0, gtid, gthreads);
    }
    conv_sample_caches(p, 0, gthreads);
    for (int t = bid; t < NTILE; t += G) {
        const int row0 = t * 64;
        if (t < 4) norm_rows<0, 3>(p.in[0] + (size_t)row0 * DM, p.in[1] + (size_t)(32 * t) * DM, p.out + (size_t)row0 * DM, tile_d2(t), (bf16_t*)(ws + OFF_XB) + (size_t)row0 * DM, nullptr);
    }
    for (int t = bid; t < NTILE; t += G) {
        const int row0 = t * 64;
        if (t >= 4) norm_rows<0, 2>(p.in[0] + (size_t)row0 * DM, p.in[1], p.out + (size_t)row0 * DM, 0, (bf16_t*)(ws + OFF_XB) + (size_t)row0 * DM, nullptr);
    }
    for (int e = bid; e < 8; e += G) if (e >= 4) norm_rows<1, 2>(nullptr, nullptr, (float*)(p.in[2] + (size_t)(e - 4) * 64 * DM), 0, (bf16_t*)(ws + OFF_MEMB) + (size_t)(e - 4) * 64 * DM, nullptr);
    { __syncthreads(); grid.sync(); }
    for (int t = bid; t < NTILE; t += G) if (t < 4) phaseA<3>(p, 0, t, lds);
    for (int t = bid; t < NTILE; t += G) if (t >= 4) phaseA<2>(p, 0, t, lds);
    for (int e = bid; e < 36; e += G) if (e >= 4) mem_kv_unit(p, e - 4, lds);
    xsync();
    for (int l = 0; l < DEPTH; ++l) {
        for (int t = bid; t < NTILE; t += G) if (t < 4) phaseB<3>(p, l, t, lds);
        for (int t = bid; t < NTILE; t += G) if (t >= 4) phaseB<2>(p, l, t, lds);
        if (l + 1 < DEPTH) {
            if (G > 8) { if (bid >= 4) pack_layer(p, l + 1, (bid - 4) * NTHR + otid(), (G - 4) * NTHR); }
            else pack_layer(p, l + 1, bid * NTHR + otid(), G * NTHR);
        }
        xsync();
        if (l + 1 < DEPTH) conv_sample_caches(p, l + 1, gthreads);

        for (int t = bid; t < NTILE; t += G) if (t < 4) { phaseC<3>(p, l, t, lds); if (l + 1 < DEPTH) phaseA<3>(p, l + 1, t, lds); }
        for (int t = bid; t < NTILE; t += G) if (t >= 4) { phaseC<2>(p, l, t, lds); if (l + 1 < DEPTH) phaseA<2>(p, l + 1, t, lds); }
        if (l + 1 < DEPTH) xsync();
    }
}

extern "C" void kernel_launch(void* const* d_in, const int* in_sizes, int n_in, void* d_out, int out_size, void* d_ws, size_t ws_size, hipStream_t stream) {
    static int grid_blocks = 0;
    if (!grid_blocks) {
        int dev = 0, cus = 0, per_cu = 0;
        (void)hipGetDevice(&dev);
        (void)hipDeviceGetAttribute(&cus, hipDeviceAttributeMultiprocessorCount, dev);
        (void)hipOccupancyMaxActiveBlocksPerMultiprocessor(&per_cu, mega, NTHR, 0);
        grid_blocks = cus * per_cu;
        if (grid_blocks > NTILE) grid_blocks = NTILE;
        if (grid_blocks < 1) grid_blocks = 1;
    }
    if (ws_size < WS_TOTAL || n_in < 29) { fprintf(stderr, "workspace too small: %zu < %zu\n", ws_size, (size_t)WS_TOTAL); return; }
    Params p{};
    for (int i = 0; i < 29; ++i) p.in[i] = (const float*)d_in[i];
    p.out = (float*)d_out;
    p.ws = (unsigned char*)d_ws;
    (void)hipMemsetAsync((unsigned char*)d_ws + OFF_BAR, 0, 16384, stream);
    void* args[] = {&p};
    hipError_t e = hipLaunchCooperativeKernel((void*)mega, dim3(grid_blocks), dim3(NTHR), args, 0, stream);
    if (e != hipSuccess) fprintf(stderr, "cooperative launch failed: %s (grid %d)\n", hipGetErrorString(e), grid_blocks);
}
```

```cpp
#include <hip/hip_runtime.h>
#include <hip/hip_cooperative_groups.h>
#include <cstdio>
#include <cstdint>
namespace cg = cooperative_groups;

#define DI __device__ __forceinline__
#ifndef DUP
#define DUP 0
#endif
typedef unsigned short bf16_t;
typedef _Float16 bf16x8 __attribute__((ext_vector_type(8)));
typedef short s16x4 __attribute__((ext_vector_type(4)));
typedef float f32x16 __attribute__((ext_vector_type(16)));
typedef float f32x4 __attribute__((ext_vector_type(4)));
typedef float f32x2 __attribute__((ext_vector_type(2)));
typedef _Float16 bf2_t __attribute__((ext_vector_type(2)));
typedef unsigned u32x4 __attribute__((ext_vector_type(4)));
typedef unsigned u32x2 __attribute__((ext_vector_type(2)));

#define MFMA32(a, b, c) __builtin_amdgcn_mfma_f32_32x32x16_f16((a), (b), (c), 0, 0, 0)

constexpr int DM = 1024, SEQ = 16384, NSMP = 128, MROWS = SEQ + NSMP, NTILE = SEQ / 64, NHALO = MROWS / 64, DEPTH = 4, NTHR = 512, NWAVE = NTHR / 64;
constexpr int DIN = 4352, DFF = 2816, DFF2 = 5632, PRIVW = 5632;
constexpr int PC_QA = 0, PC_QB = 512, PC_GA = 1024, PC_GB = 2048, PC_OA = 3072, PC_OB = 3584, PC_M = 4096, PC_QX = 5120, PC_OX = 0;
constexpr size_t PW_IN = 0, PW_OA = PW_IN + (size_t)DM * DIN, PW_OB = PW_OA + 512 * 1024, PW_OUT = PW_OB + 512 * 1024,
                 PW_XQ = PW_OUT + 1024 * 1024, PW_XO = PW_XQ + 1024 * 512, PW_UP = PW_XO + 512 * 1024,
                 PW_DOWN = PW_UP + (size_t)DM * DFF2, PW_LAYER = PW_DOWN + (size_t)DFF * DM;
constexpr size_t OFF_WP = 0;
constexpr size_t OFF_XB = OFF_WP + PW_LAYER * 2 * DEPTH;
constexpr size_t OFF_PRIV = OFF_XB + (size_t)MROWS * DM * 2;
constexpr size_t OFF_KA = OFF_PRIV + (size_t)MROWS * PRIVW * 2;
constexpr size_t OFF_VTA = OFF_KA + (size_t)MROWS * 128 * 2;
constexpr size_t OFF_KB = OFF_VTA + (size_t)MROWS * 128 * 2;
constexpr size_t OFF_VTB = OFF_KB + (size_t)MROWS * 512 * 2;
constexpr size_t OFF_UHALO = OFF_VTB + (size_t)MROWS * 512 * 2;
constexpr size_t OFF_MEMB = OFF_UHALO + (size_t)NHALO * 2 * DFF2 * 4;
constexpr size_t OFF_MK = OFF_MEMB + 256 * 1024 * 2;
constexpr size_t OFF_MVT = OFF_MK + (size_t)DEPTH * 256 * 512 * 2;
constexpr size_t OFF_SKA = OFF_MVT + (size_t)DEPTH * 256 * 512 * 2;
constexpr size_t OFF_SVTA = OFF_SKA + 8 * 128 * 128 * 2;
constexpr size_t OFF_SKB = OFF_SVTA + 8 * 128 * 128 * 2;
constexpr size_t OFF_SVTB = OFF_SKB + 8 * 512 * 512 * 2;
constexpr size_t OFF_SMK = OFF_SVTB + 8 * 512 * 512 * 2;
constexpr size_t OFF_SMVT = OFF_SMK + 8 * 256 * 512 * 2;
constexpr size_t OFF_BAR = OFF_SMVT + 8 * 256 * 512 * 2;
constexpr size_t WS_TOTAL = OFF_BAR + 16384;
constexpr size_t O_Y = 0, O_PAK = (size_t)MROWS * DM, O_PAV = O_PAK + 4 * 128 * 128, O_PBK = O_PAV + 4 * 128 * 128, O_PBV = O_PBK + 4 * 512 * 512,
                 O_PMK = O_PBV + 4 * 512 * 512, O_PMV = O_PMK + 4 * 256 * 512, O_PCONV = O_PMV + 4 * 256 * 512, O_SAK = O_PCONV + 4 * 2 * DFF2,
                 O_SAV = O_SAK + 4 * 128 * 128, O_SBK = O_SAV + 4 * 128 * 128, O_SBV = O_SBK + 4 * 128 * 512, O_SCONV = O_SBV + 4 * 128 * 512;

constexpr int A_CHUNK = 128, A_LD = A_CHUNK * 2 + 16, A_BUF = 96 * A_LD;
constexpr int ARES_LD = 1024 * 2 + 16;
constexpr int LDS_BYTES = 64 * ARES_LD > 2 * A_BUF ? 64 * ARES_LD : 2 * A_BUF;
constexpr float LOG2E = 1.4426950408889634f;
constexpr int NT = 2, UW = NT * 32;

struct Params {
    const float* in[29];
    float* out;
    unsigned char* ws;
};

DI void lds_barrier() { asm volatile("s_waitcnt lgkmcnt(0)\n\ts_barrier" ::: "memory"); }
DI int otid() { int t = threadIdx.x; asm volatile("" : "+v"(t)); return t; }
DI unsigned pk2(float lo, float hi) { f32x2 v = {lo, hi}; bf2_t b = __builtin_convertvector(v, bf2_t); return __builtin_bit_cast(unsigned, b); }
DI bf16_t cv1(float x) { return (bf16_t)(pk2(x, 0.f) & 0xffffu); }
DI float bf2f(bf16_t v) { return (float)__builtin_bit_cast(_Float16, v); }
DI int crow(int i, int h) { return (i & 3) + 8 * (i >> 2) + 4 * h; }
DI float sigm(float x) { return 1.f / (1.f + __expf(-x)); }

DI void pack_w(const float* __restrict__ W, const float* __restrict__ g, int K, int N, bf16_t* dst, int mode, int gtid, int gthreads) {
    const int KS = K / 16, NTt = N / 32, total = NTt * KS * 16;
    for (int idx = gtid; idx < total; idx += gthreads) {
        const int rq = idx & 7, h = (idx >> 3) & 1, blk = idx >> 4, nt = blk % NTt, ks = blk / NTt;
        const int n = nt * 32 + 4 * rq, k0 = ks * 16 + 8 * h;
        float sc = 1.f;
        if (mode == 1) { if (n < 512 || (n >= 768 && n < 1280)) sc = 0.125f; }
        else if (mode == 2) sc = 0.08838834764831845f;
        f32x4 v[8];
#pragma unroll
        for (int j = 0; j < 8; ++j) v[j] = *(const f32x4*)(W + (size_t)(k0 + j) * N + n) * ((g ? g[k0 + j] : 1.f) * sc);
        u32x4* o = (u32x4*)dst + (size_t)blk * 64 + h * 32 + 4 * rq;
#pragma unroll
        for (int e = 0; e < 4; ++e) { u32x4 w = {pk2(v[0][e], v[1][e]), pk2(v[2][e], v[3][e]), pk2(v[4][e], v[5][e]), pk2(v[6][e], v[7][e])}; o[e] = w; }
    }
}
DI void conv_kp(const float* __restrict__ src, bf16_t* dst, int B, int R, int H, int HD, int gtid, int gthreads) {
    const int C = H * HD, C8 = C / 8, KSQ = HD / 16, total = B * R * C8;
    for (int idx = gtid; idx < total; idx += gthreads) {
        const int c8 = idx % C8, t2 = idx / C8, t = t2 % R, b = t2 / R;
        const f32x4* sp = (const f32x4*)(src + ((size_t)b * R + t) * C + c8 * 8);
        const f32x4 v0 = sp[0], v1 = sp[1];
        const int col = c8 * 8, hd = col / HD, d = col % HD;
        const size_t o16 = ((((size_t)b * (R / 32) + (t >> 5)) * H + hd) * KSQ + (d >> 4)) * 64 + (t & 31) + 32 * ((d >> 3) & 1);
        u32x4 w = {pk2(v0[0], v0[1]), pk2(v0[2], v0[3]), pk2(v1[0], v1[1]), pk2(v1[2], v1[3])};
        ((u32x4*)dst)[o16] = w;
    }
}
DI void conv_vp(const float* __restrict__ src, bf16_t* dst, int B, int R, int C, int gtid, int gthreads) {
    const int DTt = C / 32, total = B * (R / 16) * DTt * 64;
    for (int idx = gtid; idx < total; idx += gthreads) {
        const int lane = idx & 63, f = idx >> 6, sp_ = f & 1, f2 = f >> 1, dd = f2 % DTt, f3 = f2 / DTt, tb = f3 % (R / 32), b = f3 / (R / 32);
        const int r = lane & 31, h = lane >> 5;
        const float* s0 = src + ((size_t)b * R + 32 * tb + 16 * sp_ + 4 * h) * C + dd * 32 + r;
        float v[8];
#pragma unroll
        for (int j = 0; j < 8; ++j) v[j] = s0[(size_t)(8 * (j >> 2) + (j & 3)) * C];
        u32x4 w = {pk2(v[0], v[1]), pk2(v[2], v[3]), pk2(v[4], v[5]), pk2(v[6], v[7])};
        ((u32x4*)dst)[idx] = w;
    }
}
DI void conv_sample_caches(const Params& p, int l, int gthreads) {
    unsigned char* ws = p.ws;
    const int gtid = blockIdx.x * NTHR + otid();
    conv_kp(p.in[3] + (size_t)l * 8 * 128 * 128, (bf16_t*)(ws + OFF_SKA), 8, 128, 2, 64, gtid, gthreads);
    conv_vp(p.in[4] + (size_t)l * 8 * 128 * 128, (bf16_t*)(ws + OFF_SVTA), 8, 128, 128, gtid, gthreads);
    conv_kp(p.in[5] + (size_t)l * 8 * 512 * 512, (bf16_t*)(ws + OFF_SKB), 8, 512, 8, 64, gtid, gthreads);
    conv_vp(p.in[6] + (size_t)l * 8 * 512 * 512, (bf16_t*)(ws + OFF_SVTB), 8, 512, 512, gtid, gthreads);
    conv_kp(p.in[7] + (size_t)l * 8 * 256 * 512, (bf16_t*)(ws + OFF_SMK), 8, 256, 4, 128, gtid, gthreads);
    conv_vp(p.in[8] + (size_t)l * 8 * 256 * 512, (bf16_t*)(ws + OFF_SMVT), 8, 256, 512, gtid, gthreads);
}
template <int MODE, int MT> DI void norm_rows(const float* src, const float* src2, float* x, int d2, bf16_t* xb, const float* __restrict__ g) {
    const int tid_ = otid(), wave = tid_ >> 6, lane = tid_ & 63;
    for (int rb = 0; rb < MT; ++rb) {
        f32x4 v[4][4]; float ss[4];
#pragma unroll
        for (int q = 0; q < 4; ++q) {
            const int row = wave * (MT * 4) + rb * 4 + q, grow = row + (row >= 64 ? d2 : 0);
            const float* s = x + (size_t)grow * DM;
            if (MODE == 0) { s = src + (size_t)row * DM; if (MT == 3 && row >= 64) s = src2 + (size_t)(row - 64) * DM; }
            ss[q] = 0.f;
#pragma unroll
            for (int i = 0; i < 4; ++i) { v[q][i] = *(const f32x4*)(s + i * 256 + lane * 4); ss[q] += v[q][i][0] * v[q][i][0] + v[q][i][1] * v[q][i][1] + v[q][i][2] * v[q][i][2] + v[q][i][3] * v[q][i][3]; }
        }
#pragma unroll
        for (int o = 32; o >= 1; o >>= 1)
#pragma unroll
            for (int q = 0; q < 4; ++q) ss[q] += __shfl_xor(ss[q], o);
#pragma unroll
        for (int q = 0; q < 4; ++q) {
            const int row = wave * (MT * 4) + rb * 4 + q, grow = row + (row >= 64 ? d2 : 0);
            const float rstd = rsqrtf(ss[q] * (1.f / DM) + 1e-6f);
#pragma unroll
            for (int i = 0; i < 4; ++i) {
                if (MODE == 0) *(f32x4*)(x + (size_t)grow * DM + i * 256 + lane * 4) = v[q][i];
                if (MODE == 2) { f32x4 gg = *(const f32x4*)(g + i * 256 + lane * 4); *(f32x4*)(x + (size_t)grow * DM + i * 256 + lane * 4) = v[q][i] * rstd * gg; }
                else { u32x2 o = {pk2(v[q][i][0] * rstd, v[q][i][1] * rstd), pk2(v[q][i][2] * rstd, v[q][i][3] * rstd)}; *(u32x2*)(xb + (size_t)grow * DM + i * 256 + lane * 4) = o; }
            }
        }
    }
}

struct EpiNull { float* sink;
    template <int MT> DI void operator()(int, const f32x16 (&acc)[MT][NT]) const {
        float s = 0.f;
#pragma unroll
        for (int mi = 0; mi < MT; ++mi)
#pragma unroll
            for (int nj = 0; nj < NT; ++nj)
#pragma unroll
                for (int i = 0; i < 16; ++i) s += acc[mi][nj][i];
        if (s == 1.2345e30f) *sink = s;
    } };
template <int K, class Epi>
DI void gemm64_res(const bf16_t* A, int lda, const bf16_t* Wp, int NU, unsigned char* lds, const Epi& epi) {
    constexpr int KS = K / 16, PD = 4, LD = K * 2 + 16, SEGS = K / 8, NIT = 64 * SEGS / NTHR;
    const int tid = otid(), wave = __builtin_amdgcn_readfirstlane(tid >> 6), lane = tid & 63, r = lane & 31, h = lane >> 5;
    const u32x4* Bw = (const u32x4*)Wp;
    const size_t kstr = (size_t)NU * NT * 64;
    __syncthreads();
#pragma unroll
    for (int i0 = 0; i0 < NIT; i0 += 8) {
        u32x4 t8[8];
#pragma unroll
        for (int i = 0; i < 8; ++i) { const int idx = (i0 + i) * NTHR + tid, row = idx / SEGS, seg = idx % SEGS; t8[i] = *(const u32x4*)(A + (row * lda + seg * 8)); }
#pragma unroll
        for (int i = 0; i < 8; ++i) { const int idx = (i0 + i) * NTHR + tid, row = idx / SEGS, seg = idx % SEGS; *(u32x4*)(lds + row * LD + seg * 16) = t8[i]; }
    }
    __syncthreads();
    const unsigned char* ab = lds + r * LD + 16 * h;
#pragma unroll 1
    for (int unit = wave; unit < NU; unit += NWAVE) {
        const u32x4* bp = Bw + (size_t)(unit * NT) * 64 + lane;
        f32x16 acc[2][NT];
#pragma unroll
        for (int mi = 0; mi < 2; ++mi)
#pragma unroll
            for (int nj = 0; nj < NT; ++nj)
#pragma unroll
                for (int i = 0; i < 16; ++i) acc[mi][nj][i] = 0.f;
        u32x4 bq[PD][NT];
#pragma unroll
        for (int s = 0; s < PD; ++s)
#pragma unroll
            for (int j = 0; j < NT; ++j) bq[s][j] = bp[(size_t)s * kstr + j * 64];
#pragma unroll 1
        for (int kk = 0; kk < KS; kk += PD) {
#pragma unroll
            for (int s = 0; s < PD; ++s) {
                const int ks = kk + s;
                const bf16x8 a0 = *(const bf16x8*)(ab + ks * 32), a1 = *(const bf16x8*)(ab + 32 * LD + ks * 32);
#pragma unroll
                for (int j = 0; j < NT; ++j) { acc[0][j] = MFMA32(a0, __builtin_bit_cast(bf16x8, bq[s][j]), acc[0][j]); acc[1][j] = MFMA32(a1, __builtin_bit_cast(bf16x8, bq[s][j]), acc[1][j]); }
                int nk = ks + PD; nk = nk < KS ? nk : KS - 1;
#pragma unroll
                for (int j = 0; j < NT; ++j) bq[s][j] = bp[(size_t)nk * kstr + j * 64];
                __builtin_amdgcn_sched_barrier(0);
            }
        }
        epi(unit, acc);
    }
}

template <int K, int MT, class Epi, int XM = 0>
DI void gemm64(const bf16_t* A, int lda, int d2, const bf16_t* Wp, int NU, unsigned char* lds, const Epi& epi) {
    if constexpr (MT == 2 && K <= 1024 && XM == 0) { gemm64_res<K>(A, lda, Wp, NU, lds, epi); return; }
    constexpr int KS = K / 16, NCH = K / A_CHUNK, PD = 4;
    const int tid = otid(), wave = tid >> 6, lane = tid & 63, r = lane & 31, h = lane >> 5;
    const u32x4* Bw = (const u32x4*)Wp;
#pragma unroll 1
    for (int pass = 0; pass * NWAVE < NU; ++pass) {
        const int unit = pass * NWAVE + wave;
        const bool active = unit < NU;
        const int ucl = active ? unit : NU - 1;
        const u32x4* bp = Bw + (size_t)(ucl * NT) * 64 + lane;
        const size_t kstr = (size_t)NU * NT * 64;
        f32x16 acc[MT][NT];
#pragma unroll
        for (int mi = 0; mi < MT; ++mi)
#pragma unroll
            for (int nj = 0; nj < NT; ++nj)
#pragma unroll
                for (int i = 0; i < 16; ++i) acc[mi][nj][i] = 0.f;
        u32x4 bq[PD][NT];
#pragma unroll
        for (int s = 0; s < PD; ++s)
#pragma unroll
            for (int j = 0; j < NT; ++j) bq[s][j] = bp[(size_t)s * kstr + j * 64];
        u32x4 areg[MT];
        if (pass == 0) __syncthreads();
#pragma unroll
        for (int i = 0; i < MT; ++i) { const int idx = i * NTHR + tid, row = idx >> 4, seg = idx & 15; areg[i] = *(const u32x4*)(A + ((row + (i == 2 ? d2 : 0)) * lda + seg * 8)); }
#pragma unroll
        for (int i = 0; i < MT; ++i) { const int idx = i * NTHR + tid, row = idx >> 4, seg = idx & 15; *(u32x4*)(lds + row * A_LD + seg * 16) = areg[i]; }
        lds_barrier();
#pragma unroll 1
        for (int c = 0; c < NCH; ++c) {
            if (c + 1 < NCH) {
#pragma unroll
                for (int i = 0; i < MT; ++i) { const int idx = i * NTHR + tid, row = idx >> 4, seg = idx & 15; areg[i] = *(const u32x4*)(A + ((row + (i == 2 ? d2 : 0)) * lda + (c + 1) * A_CHUNK + seg * 8)); }
            }
            const unsigned char* ab = lds + (c & 1) * A_BUF + r * A_LD + 16 * h;
            if (active) {
                bf16x8 a[MT], n[MT];
#pragma unroll
                for (int mi = 0; mi < MT; ++mi) a[mi] = *(const bf16x8*)(ab + mi * 32 * A_LD);
#pragma unroll
                for (int ks = 0; ks < A_CHUNK / 16; ++ks) {
#pragma unroll
                    for (int mi = 0; mi < MT; ++mi) n[mi] = a[mi];
                    if (ks + 1 < A_CHUNK / 16) {
#pragma unroll
                        for (int mi = 0; mi < MT; ++mi) n[mi] = *(const bf16x8*)(ab + mi * 32 * A_LD + (ks + 1) * 32);
                    }
#pragma unroll
                    for (int j = 0; j < NT; ++j)
#pragma unroll
                        for (int mi = 0; mi < MT; ++mi) acc[mi][j] = MFMA32(a[mi], __builtin_bit_cast(bf16x8, bq[ks % PD][j]), acc[mi][j]);
                    int nk = c * (A_CHUNK / 16) + ks + PD; nk = nk < KS ? nk : KS - 1;
#pragma unroll
                    for (int j = 0; j < NT; ++j) { if (XM == 0) bq[ks % PD][j] = bp[(size_t)nk * kstr + j * 64]; else if (XM == 1) bq[ks % PD][j] = bp[(size_t)(nk & 7) * 128 + j * 64]; }
                    __builtin_amdgcn_sched_barrier(0);
#pragma unroll
                    for (int mi = 0; mi < MT; ++mi) a[mi] = n[mi];
                }
            }
            if (c + 1 < NCH) {
                unsigned char* wb = lds + ((c + 1) & 1) * A_BUF;
#pragma unroll
                for (int i = 0; i < MT; ++i) { const int idx = i * NTHR + tid, row = idx >> 4, seg = idx & 15; *(u32x4*)(wb + row * A_LD + seg * 16) = areg[i]; }
            }
            lds_barrier();
        }
        if (active) epi(unit, acc);
    }
}

template <int MT> DI void st_bf16(bf16_t* base, int ld, int d2, int col0, const f32x16 (&acc)[MT][NT]) {
    const int lane = otid() & 63, r = lane & 31, h = lane >> 5;
#pragma unroll
    for (int mi = 0; mi < MT; ++mi)
#pragma unroll
        for (int nj = 0; nj < NT; ++nj)
#pragma unroll
            for (int i = 0; i < 16; ++i) base[(mi * 32 + crow(i, h) + (mi == 2 ? d2 : 0)) * ld + col0 + nj * 32 + r] = cv1(acc[mi][nj][i]);
}
template <int MI0, int MI1, int MT> DI void st_f32(float* base, int ld, int col0, const f32x16 (&acc)[MT][NT]) {
    const int lane = otid() & 63, r = lane & 31, h = lane >> 5;
#pragma unroll
    for (int mi = MI0; mi < MI1; ++mi)
#pragma unroll
        for (int nj = 0; nj < NT; ++nj)
#pragma unroll
            for (int i = 0; i < 16; ++i) base[((mi - MI0) * 32 + crow(i, h)) * ld + col0 + nj * 32 + r] = acc[mi][nj][i];
}
template <int MT> DI void st_kp(bf16_t* kp, int H, int KSQ, int hd, int dbase, int tb0, int tb2, const f32x16 (&acc)[MT][NT]) {
    const int lane = otid() & 63, r = lane & 31, h = lane >> 5;
#pragma unroll
    for (int mi = 0; mi < MT; ++mi)
#pragma unroll
        for (int nj = 0; nj < NT; ++nj) {
            const int tb = mi == 2 ? tb2 : tb0 + mi, d = dbase + nj * 32 + r;
            bf16_t* fp = kp + ((tb * H + hd) * KSQ + (d >> 4)) * 512 + 32 * ((d >> 3) & 1) * 8 + (d & 7);
#pragma unroll
            for (int i = 0; i < 16; ++i) fp[crow(i, h) * 8] = cv1(acc[mi][nj][i]);
        }
}
template <int MT> DI void st_vp(bf16_t* vp, int DTt, int dd0, int tb0, int tb2, const f32x16 (&acc)[MT][NT]) {
    const int lane = otid() & 63;
#pragma unroll
    for (int mi = 0; mi < MT; ++mi)
#pragma unroll
        for (int nj = 0; nj < NT; ++nj)
#pragma unroll
            for (int sp_ = 0; sp_ < 2; ++sp_) {
                const int tb = mi == 2 ? tb2 : tb0 + mi;
                u32x4 w = {pk2(acc[mi][nj][8 * sp_], acc[mi][nj][8 * sp_ + 1]), pk2(acc[mi][nj][8 * sp_ + 2], acc[mi][nj][8 * sp_ + 3]),
                           pk2(acc[mi][nj][8 * sp_ + 4], acc[mi][nj][8 * sp_ + 5]), pk2(acc[mi][nj][8 * sp_ + 6], acc[mi][nj][8 * sp_ + 7])};
                *(u32x4*)(vp + ((((tb * DTt + dd0 + nj) * 2 + sp_) * 64 + lane) * 8)) = w;
            }
}

template <int MT> struct EpiMixIn {
    bf16_t* priv; bf16_t *ka, *kb, *vta, *vtb; int d2, tb0, tb2;
    float *oak, *oav, *obk, *obv;
    float *sak, *sav, *sbk, *sbv;
    DI void operator()(int unit, const f32x16 (&acc)[MT][NT]) const {
        if (unit < 8) st_bf16<MT>(priv, PRIVW, d2, PC_QA + unit * UW, acc);
        else if (unit < 10) { st_kp<MT>(ka, 2, 4, unit - 8, 0, tb0, tb2, acc); if (oak) st_f32<0, 2, MT>(oak, 128, (unit - 8) * UW, acc); if (MT == 3) st_f32<2, MT, MT>(sak, 128, (unit - 8) * UW, acc); }
        else if (unit < 12) { st_vp<MT>(vta, 4, (unit - 10) * 2, tb0, tb2, acc); if (oav) st_f32<0, 2, MT>(oav, 128, (unit - 10) * UW, acc); if (MT == 3) st_f32<2, MT, MT>(sav, 128, (unit - 10) * UW, acc); }
        else if (unit < 20) st_bf16<MT>(priv, PRIVW, d2, PC_QB + (unit - 12) * UW, acc);
        else if (unit < 28) { st_kp<MT>(kb, 8, 4, unit - 20, 0, tb0, tb2, acc); if (obk) st_f32<0, 2, MT>(obk, 512, (unit - 20) * UW, acc); if (MT == 3) st_f32<2, MT, MT>(sbk, 512, (unit - 20) * UW, acc); }
        else if (unit < 36) { st_vp<MT>(vtb, 16, (unit - 28) * 2, tb0, tb2, acc); if (obv) st_f32<0, 2, MT>(obv, 512, (unit - 28) * UW, acc); if (MT == 3) st_f32<2, MT, MT>(sbv, 512, (unit - 28) * UW, acc); }
        else {
            const int lane = otid() & 63, r = lane & 31, h = lane >> 5;
            const int col0 = PC_GA + (unit - 36) * UW;
#pragma unroll
            for (int mi = 0; mi < MT; ++mi)
#pragma unroll
                for (int nj = 0; nj < NT; ++nj)
#pragma unroll
                    for (int i = 0; i < 16; ++i) priv[(mi * 32 + crow(i, h) + (mi == 2 ? d2 : 0)) * PRIVW + col0 + nj * 32 + r] = cv1(sigm(acc[mi][nj][i]));
        }
    }
};
template <int MT, int SECOND> struct EpiGate {
    bf16_t* priv; int gcol; int d2;
    DI void operator()(int unit, const f32x16 (&acc)[MT][NT]) const {
        const int lane = otid() & 63, r = lane & 31, h = lane >> 5;
#pragma unroll
        for (int mi = 0; mi < MT; ++mi)
#pragma unroll
            for (int nj = 0; nj < NT; ++nj)
#pragma unroll
                for (int i = 0; i < 16; ++i) {
                    bf16_t* rowp = priv + (mi * 32 + crow(i, h) + (mi == 2 ? d2 : 0)) * PRIVW; const int c = unit * UW + nj * 32 + r;
                    float v = bf2f(rowp[gcol + c]) * acc[mi][nj][i];
                    if (SECOND) v += bf2f(rowp[PC_M + c]);
                    rowp[PC_M + c] = cv1(v);
                    if (i == 15) __builtin_amdgcn_sched_barrier(0);
                }
    }
};
template <int MT> struct EpiResid {
    float* x; int d2;
    DI void operator()(int unit, const f32x16 (&acc)[MT][NT]) const {
        const int lane = otid() & 63, r = lane & 31, h = lane >> 5;
#pragma unroll
        for (int mi = 0; mi < MT; ++mi)
#pragma unroll
            for (int nj = 0; nj < NT; ++nj)
#pragma unroll
                for (int i = 0; i < 16; ++i) { float* q = x + ((mi * 32 + crow(i, h) + (mi == 2 ? d2 : 0)) * DM + unit * UW + nj * 32 + r); *q = *q + acc[mi][nj][i]; if (i == 15) __builtin_amdgcn_sched_barrier(0); }
    }
};
template <int MT> struct EpiStore { bf16_t* base; int ld; int col0; int d2;
    DI void operator()(int unit, const f32x16 (&acc)[MT][NT]) const { st_bf16<MT>(base, ld, d2, col0 + unit * UW, acc); } };
template <int MT> struct EpiUp {
    bf16_t* priv; float* halo; float* pconv; float* sconv; int d2;
    DI void operator()(int unit, const f32x16 (&acc)[MT][NT]) const {
        st_bf16<MT>(priv, PRIVW, d2, unit * UW, acc);
        const int lane = otid() & 63, r = lane & 31, h = lane >> 5;
#pragma unroll
        for (int mi = 1; mi < MT; ++mi)
#pragma unroll
            for (int nj = 0; nj < NT; ++nj)
#pragma unroll
                for (int i = 0; i < 16; ++i) {
                    const int lr = mi * 32 + crow(i, h), c = unit * UW + nj * 32 + r;
                    if (mi == 1) { if (lr >= 62) { halo[(lr - 62) * DFF2 + c] = acc[mi][nj][i]; if (pconv) pconv[(lr - 62) * DFF2 + c] = acc[mi][nj][i]; } }
                    else if ((lr & 15) >= 14) sconv[(((lr - 64) >> 4) * 2 + ((lr & 15) - 14)) * DFF2 + c] = acc[mi][nj][i];
                }
    }
};
struct EpiMemKV { bf16_t* kp; bf16_t* vp; float* o; int isv; int tb0;
    DI void operator()(int unit, const f32x16 (&acc)[2][NT]) const {
        if (isv) st_vp<2>(vp, 16, unit * 2, tb0, 0, acc); else st_kp<2>(kp, 4, 8, unit >> 1, (unit & 1) * 64, tb0, 0, acc);
        st_f32<0, 2, 2>(o, 512, unit * UW, acc);
    } };

template <int HD, int BIAS, bool FULL>
DI void attn_block(const bf16_t* Kb, int ktb, const bf16_t* Vb, int vtb, int koff, int kpos0, int qp, float slope, const float* rel,
                   const bf16x8 (&qf)[HD / 16], f32x16 (&o)[HD / 32], float& m, float& l) {
    constexpr int KSQ = HD / 16, DT = HD / 32, NKT = FULL ? 2 : 1;
    constexpr bool VTOP = HD == 64;
    const int lane = otid() & 63, h = lane >> 5;
    const int kbeg = FULL ? 0 : koff, kend = FULL ? 64 : koff + 16;
    const int s0 = FULL ? 0 : (koff >> 4);
    int dq = kpos0 + 4 * h - qp; asm volatile("" : "+v"(dq));
    bf16x8 kreg[NKT][KSQ];
#pragma unroll
    for (int kt = 0; kt < NKT; ++kt)
#pragma unroll
        for (int ks = 0; ks < KSQ; ++ks) kreg[kt][ks] = *(const bf16x8*)(Kb + (size_t)kt * ktb + ks * 512 + lane * 8);
    constexpr int NS = FULL ? 4 : 1;
    bf16x8 vreg[DT][NS];
    auto loadV = [&]() {
#pragma unroll
        for (int si = 0; si < NS; ++si)
#pragma unroll
            for (int dt = 0; dt < DT; ++dt) { const int s = FULL ? si : s0; vreg[dt][si] = *(const bf16x8*)(Vb + (size_t)(s >> 1) * vtb + dt * 1024 + (s & 1) * 512 + lane * 8); }
    };
    if (VTOP) loadV();
    __builtin_amdgcn_sched_barrier(0);
    f32x16 st[NKT];
#pragma unroll
    for (int kt = 0; kt < NKT; ++kt) {
#pragma unroll
        for (int i = 0; i < 16; ++i) st[kt][i] = 0.f;
#pragma unroll
        for (int ks = 0; ks < KSQ; ++ks) st[kt] = MFMA32(kreg[kt][ks], qf[ks], st[kt]);
    }
    __builtin_amdgcn_sched_barrier(0);
    if (!VTOP) loadV();
    float mx = -1e30f;
#pragma unroll
    for (int kt = 0; kt < NKT; ++kt)
#pragma unroll
        for (int i = 0; i < 16; ++i) {
            const int key = kt * 32 + crow(i, h);
            float s = st[kt][i];
            const int dk = dq + (kt * 32 + (i & 3) + 8 * (i >> 2));
            if (BIAS == 1) s -= slope * (float)(dk < 0 ? -dk : dk);
            if (BIAS == 2) { int d = dk < -256 ? -256 : (dk > 256 ? 256 : dk); s += rel[d + 256]; }
            if (!FULL) { if (key < kbeg || key >= kend) s = -1e30f; }
            st[kt][i] = s; mx = fmaxf(mx, s);
        }
    mx = fmaxf(mx, __shfl_xor(mx, 32));
    const float mn = fmaxf(m, mx);
    const float alpha = __builtin_amdgcn_exp2f((m - mn) * LOG2E);
    m = mn;
    float ps = 0.f;
#pragma unroll
    for (int kt = 0; kt < NKT; ++kt)
#pragma unroll
        for (int i = 0; i < 16; ++i) { const float pv = __builtin_amdgcn_exp2f((st[kt][i] - mn) * LOG2E); st[kt][i] = pv; ps += pv; }
    l = l * alpha + ps;
#pragma unroll
    for (int dt = 0; dt < DT; ++dt)
#pragma unroll
        for (int i = 0; i < 16; ++i) o[dt][i] *= alpha;
#pragma unroll
    for (int si = 0; si < NS; ++si) {
        u32x4 pw;
        if (FULL) { const int kt = si >> 1, b0 = (si & 1) * 8; pw = (u32x4){pk2(st[kt][b0], st[kt][b0 + 1]), pk2(st[kt][b0 + 2], st[kt][b0 + 3]), pk2(st[kt][b0 + 4], st[kt][b0 + 5]), pk2(st[kt][b0 + 6], st[kt][b0 + 7])}; }
        else {
            const u32x4 lo = {pk2(st[0][0], st[0][1]), pk2(st[0][2], st[0][3]), pk2(st[0][4], st[0][5]), pk2(st[0][6], st[0][7])};
            const u32x4 hi = {pk2(st[0][8], st[0][9]), pk2(st[0][10], st[0][11]), pk2(st[0][12], st[0][13]), pk2(st[0][14], st[0][15])};
            pw = (s0 & 1) ? hi : lo;
        }
        const bf16x8 pf = __builtin_bit_cast(bf16x8, pw);
#pragma unroll
        for (int dt = 0; dt < DT; ++dt) o[dt] = MFMA32(vreg[dt][si], pf, o[dt]);
    }
}

template <int HD, int BIAS>
DI void attn_item(const bf16_t* Q, int qstride, int nq, int qpos0,
                  const bf16_t* K1, int ktb1, const bf16_t* V1, int vtb1, int nb1, int pos1,
                  const bf16_t* K2, const bf16_t* V2, int nb2, int pos2, int koff2,
                  float m0, float l0, float slope, const float* rel, bf16_t* O, int ostride) {
    constexpr int KSQ = HD / 16, DT = HD / 32;
    const int lane = otid() & 63, r = lane & 31, h = lane >> 5;
    const int qr = r < nq ? r : nq - 1;
    bf16x8 qf[KSQ];
#pragma unroll
    for (int ks = 0; ks < KSQ; ++ks) qf[ks] = *(const bf16x8*)(Q + (size_t)qr * qstride + ks * 16 + 8 * h);
    f32x16 o[DT];
#pragma unroll
    for (int dt = 0; dt < DT; ++dt)
#pragma unroll
        for (int i = 0; i < 16; ++i) o[dt][i] = 0.f;
    float m = m0, l = h == 0 ? l0 : 0.f;
    const int qp = qpos0 + qr;
#pragma unroll 1
    for (int blk = 0; blk < nb1; ++blk)
        attn_block<HD, BIAS, true>(K1 + (size_t)(2 * blk) * ktb1, ktb1, V1 + (size_t)(2 * blk) * vtb1, vtb1, 0, pos1 + blk * 64, qp, slope, rel, qf, o, m, l);
    if (nb2) attn_block<HD, BIAS, false>(K2, 0, V2, 0, koff2, pos2 - koff2, qp, slope, rel, qf, o, m, l);
    const float lt = l + __shfl_xor(l, 32);
    const float inv = 1.f / lt;
    if (r < nq) {
#pragma unroll
        for (int dt = 0; dt < DT; ++dt)
#pragma unroll
            for (int g = 0; g < 4; ++g) {
                u32x2 w = {pk2(o[dt][4 * g] * inv, o[dt][4 * g + 1] * inv), pk2(o[dt][4 * g + 2] * inv, o[dt][4 * g + 3] * inv)};
                *(u32x2*)(O + (size_t)r * ostride + dt * 32 + 8 * g + 4 * h) = w;
            }
    }
}

DI const bf16_t* wp(const Params& p, int l, size_t off) { return (const bf16_t*)(p.ws + OFF_WP) + (size_t)l * PW_LAYER + off; }
DI int tile_d2(int t) { return SEQ + 32 * t - (64 * t + 64); }

template <int MT> DI void phaseA(const Params& p, int l, int t, unsigned char* lds) {
    const int row0 = t * 64, d2 = MT == 3 ? tile_d2(t) : 0;
    unsigned char* ws = p.ws;
    EpiMixIn<MT> e;
    e.priv = (bf16_t*)(ws + OFF_PRIV) + (size_t)row0 * PRIVW;
    e.ka = (bf16_t*)(ws + OFF_KA); e.kb = (bf16_t*)(ws + OFF_KB); e.vta = (bf16_t*)(ws + OFF_VTA); e.vtb = (bf16_t*)(ws + OFF_VTB);
    e.tb0 = 2 * t; e.tb2 = SEQ / 32 + t;
    e.d2 = d2;
    e.oak = e.oav = e.obk = e.obv = nullptr;
    e.sak = e.sav = e.sbk = e.sbv = nullptr;
    if (row0 >= SEQ - 128) { const int pr = row0 - (SEQ - 128); e.oak = p.out + O_PAK + (size_t)l * 128 * 128 + (size_t)pr * 128; e.oav = p.out + O_PAV + (size_t)l * 128 * 128 + (size_t)pr * 128; }
    if (row0 >= SEQ - 512) { const int pr = row0 - (SEQ - 512); e.obk = p.out + O_PBK + (size_t)l * 512 * 512 + (size_t)pr * 512; e.obv = p.out + O_PBV + (size_t)l * 512 * 512 + (size_t)pr * 512; }
    if (MT == 3) {
        const int sr = 32 * t;
        e.sak = p.out + O_SAK + (size_t)l * 128 * 128 + (size_t)sr * 128; e.sav = p.out + O_SAV + (size_t)l * 128 * 128 + (size_t)sr * 128;
        e.sbk = p.out + O_SBK + (size_t)l * 128 * 512 + (size_t)sr * 512; e.sbv = p.out + O_SBV + (size_t)l * 128 * 512 + (size_t)sr * 512;
    }
    gemm64<1024, MT>((const bf16_t*)(ws + OFF_XB) + (size_t)row0 * DM, DM, d2, wp(p, l, PW_IN), DIN / UW, lds, e);
#if DUP >= 2
    gemm64<1024, MT, EpiNull, DUP - 2>((const bf16_t*)(ws + OFF_XB) + (size_t)row0 * DM, DM, d2, wp(p, l, PW_IN), DIN / UW, lds, EpiNull{p.out});
#endif
}

DI void mem_kv_unit(const Params& p, int e, unsigned char* lds) {
    const int l = e >> 3, kv = (e >> 2) & 1, rt = e & 3;
    unsigned char* ws = p.ws;
    EpiMemKV ep;
    ep.kp = (bf16_t*)(ws + OFF_MK) + (size_t)l * 256 * 512;
    ep.vp = (bf16_t*)(ws + OFF_MVT) + (size_t)l * 256 * 512;
    ep.tb0 = rt * 2;
    ep.o = p.out + (kv ? O_PMV : O_PMK) + (size_t)l * 256 * 512 + (size_t)rt * 64 * 512;
    ep.isv = kv;
    gemm64<1024, 2>((const bf16_t*)(ws + OFF_MEMB) + (size_t)rt * 64 * DM, DM, 0, (const bf16_t*)(ws + OFF_UHALO) + (size_t)(l * 2 + kv) * 512 * 1024, 512 / UW, lds, ep);
}

template <int MT> DI void phaseB(const Params& p, int l, int t, unsigned char* lds) {
    const int row0 = t * 64, d2 = MT == 3 ? tile_d2(t) : 0, tid = otid(), wave = __builtin_amdgcn_readfirstlane(tid >> 6);
    unsigned char* ws = p.ws;
    bf16_t* priv = (bf16_t*)(ws + OFF_PRIV) + (size_t)row0 * PRIVW;
    bf16_t* xb = (bf16_t*)(ws + OFF_XB) + (size_t)row0 * DM;
    float* x = p.out + (size_t)row0 * DM;
    const bf16_t* KA = (const bf16_t*)(ws + OFF_KA); const bf16_t* VTA = (const bf16_t*)(ws + OFF_VTA);
    const bf16_t* KB = (const bf16_t*)(ws + OFF_KB); const bf16_t* VTB = (const bf16_t*)(ws + OFF_VTB);
    float* rel = (float*)lds;
    __syncthreads();
    for (int i = tid; i < 8 * 513; i += NTHR) rel[i] = p.in[13][(size_t)l * 8 * 513 + i];
    __syncthreads();
    const float* sink = p.in[12] + l * 8;
    for (int rep_ = 0; rep_ < (DUP == 1 ? 2 : 1); ++rep_)
    for (int it = wave; it < (MT == 3 ? 64 : 32); it += NWAVE) {
        if (it < 32) {
            const int c = t, isB = it >> 4, hq = (it >> 1) & 7, qh = it & 1;
            if (!isB) {
                const int kvh = hq >> 2, c0 = c - 2 < 0 ? 0 : c - 2;
                attn_item<64, 1>(priv + (size_t)(32 * qh) * PRIVW + PC_QA + hq * 64, PRIVW, 32, row0 + 32 * qh,
                                 KA + (size_t)(2 * c0) * 4096 + kvh * 2048, 4096, VTA + (size_t)(2 * c0) * 4096 + kvh * 2048, 4096, c - c0 + 1, 64 * c0,
                                 nullptr, nullptr, 0, 0, 0,
                                 sink[hq], 1.f, exp2f(-(float)(hq + 1)), nullptr, priv + (size_t)(32 * qh) * PRIVW + PC_OA + hq * 64, PRIVW);
            } else {
                const int c0 = c - 8 < 0 ? 0 : c - 8;
                attn_item<64, 2>(priv + (size_t)(32 * qh) * PRIVW + PC_QB + hq * 64, PRIVW, 32, row0 + 32 * qh,
                                 KB + (size_t)(2 * c0) * 16384 + hq * 2048, 16384, VTB + (size_t)(2 * c0) * 16384 + hq * 2048, 16384, c - c0 + 1, 64 * c0,
                                 nullptr, nullptr, 0, 0, 0,
                                 -1e30f, 0.f, 0.f, rel + hq * 513, priv + (size_t)(32 * qh) * PRIVW + PC_OB + hq * 64, PRIVW);
            }
        } else {
            const int j = it - 32, isB = j >> 4, bb = (j >> 3) & 1, hq = j & 7, b = 2 * t + bb;
            const size_t nrow = (size_t)SEQ + b * 16;
            const int tbn = SEQ / 32 + t, koff = bb * 16;
            bf16_t* sp = (bf16_t*)(ws + OFF_PRIV) + nrow * PRIVW;
            if (!isB) {
                const int kvh = hq >> 2;
                attn_item<64, 1>(sp + PC_QA + hq * 64, PRIVW, 16, 1024,
                                 (const bf16_t*)(ws + OFF_SKA) + (size_t)b * 16384 + kvh * 2048, 4096, (const bf16_t*)(ws + OFF_SVTA) + (size_t)b * 16384 + kvh * 2048, 4096, 2, 896,
                                 KA + (size_t)tbn * 4096 + kvh * 2048, VTA + (size_t)tbn * 4096 + kvh * 2048, 1, 1024, koff,
                                 sink[hq], 1.f, exp2f(-(float)(hq + 1)), nullptr, sp + PC_OA + hq * 64, PRIVW);
            } else {
                attn_item<64, 2>(sp + PC_QB + hq * 64, PRIVW, 16, 1024,
                                 (const bf16_t*)(ws + OFF_SKB) + (size_t)b * 262144 + hq * 2048, 16384, (const bf16_t*)(ws + OFF_SVTB) + (size_t)b * 262144 + hq * 2048, 16384, 8, 512,
                                 KB + (size_t)tbn * 16384 + hq * 2048, VTB + (size_t)tbn * 16384 + hq * 2048, 1, 1024, koff,
                                 -1e30f, 0.f, 0.f, rel + hq * 513, sp + PC_OB + hq * 64, PRIVW);
            }
        }
    }
    gemm64<512, MT>(priv + PC_OA, PRIVW, d2, wp(p, l, PW_OA), DM / UW, lds, EpiGate<MT, 0>{priv, PC_GA, d2});
    gemm64<512, MT>(priv + PC_OB, PRIVW, d2, wp(p, l, PW_OB), DM / UW, lds, EpiGate<MT, 1>{priv, PC_GB, d2});
    gemm64<1024, MT>(priv + PC_M, PRIVW, d2, wp(p, l, PW_OUT), DM / UW, lds, EpiResid<MT>{x, d2});
    __syncthreads();
    norm_rows<1, MT>(nullptr, nullptr, x, d2, xb, nullptr);
    gemm64<1024, MT>(xb, DM, d2, wp(p, l, PW_XQ), 512 / UW, lds, EpiStore<MT>{priv, PRIVW, PC_QX, d2});
    __syncthreads();
    for (int rep_ = 0; rep_ < (DUP == 1 ? 2 : 1); ++rep_)
    for (int it = wave; it < (MT == 3 ? 16 : 8); it += NWAVE) {
        if (it < 8) {
            const int hx = it >> 1, qh = it & 1;
            attn_item<128, 0>(priv + (size_t)(32 * qh) * PRIVW + PC_QX + hx * 128, PRIVW, 32, 0,
                              (const bf16_t*)(ws + OFF_MK) + (size_t)l * 131072 + hx * 4096, 16384, (const bf16_t*)(ws + OFF_MVT) + (size_t)l * 131072 + hx * 4096, 16384, 4, 0,
                              nullptr, nullptr, 0, 0, 0,
                              -1e30f, 0.f, 0.f, nullptr, priv + (size_t)(32 * qh) * PRIVW + PC_OX + hx * 128, PRIVW);
        } else {
            const int j = it - 8, bb = j >> 2, hx = j & 3, b = 2 * t + bb;
            bf16_t* sp = (bf16_t*)(ws + OFF_PRIV) + ((size_t)SEQ + b * 16) * PRIVW;
            attn_item<128, 0>(sp + PC_QX + hx * 128, PRIVW, 16, 0,
                              (const bf16_t*)(ws + OFF_SMK) + (size_t)b * 131072 + hx * 4096, 16384, (const bf16_t*)(ws + OFF_SMVT) + (size_t)b * 131072 + hx * 4096, 16384, 4, 0,
                              nullptr, nullptr, 0, 0, 0,
                              -1e30f, 0.f, 0.f, nullptr, sp + PC_OX + hx * 128, PRIVW);
        }
    }
    gemm64<512, MT>(priv + PC_OX, PRIVW, d2, wp(p, l, PW_XO), DM / UW, lds, EpiResid<MT>{x, d2});
    __syncthreads();
    norm_rows<1, MT>(nullptr, nullptr, x, d2, xb, nullptr);
    EpiUp<MT> eu; eu.priv = priv; eu.d2 = d2;
    eu.halo = (float*)(ws + OFF_UHALO) + (size_t)t * 2 * DFF2;
    eu.pconv = t == NTILE - 1 ? p.out + O_PCONV + (size_t)l * 2 * DFF2 : nullptr;
    eu.sconv = p.out + O_SCONV + ((size_t)l * 8 + 2 * t) * 2 * DFF2;
    gemm64<1024, MT>(xb, DM, d2, wp(p, l, PW_UP), DFF2 / UW, lds, eu);
}

template <int NR> DI void conv_seg(bf16_t* rows, const float* st, const float (&wg)[3][2], const float (&wu)[3][2], const float (&bg)[2], const float (&bu)[2], int j) {
    float g2[2] = {0.f, 0.f}, g1[2] = {0.f, 0.f}, u2[2] = {0.f, 0.f}, u1[2] = {0.f, 0.f};
    if (st) {
        g2[0] = st[j]; g2[1] = st[j + 1]; u2[0] = st[DFF + j]; u2[1] = st[DFF + j + 1];
        g1[0] = st[DFF2 + j]; g1[1] = st[DFF2 + j + 1]; u1[0] = st[DFF2 + DFF + j]; u1[1] = st[DFF2 + DFF + j + 1];
    }
    for (int lb = 0; lb < NR; lb += 8) {
        unsigned gwv[8], uwv[8];
#pragma unroll
        for (int q8 = 0; q8 < 8; ++q8) { const bf16_t* rp = rows + (size_t)(lb + q8) * PRIVW; gwv[q8] = *(const unsigned*)(rp + j); uwv[q8] = *(const unsigned*)(rp + DFF + j); }
#pragma unroll
        for (int q8 = 0; q8 < 8; ++q8) {
            const unsigned gw = gwv[q8], uw = uwv[q8];
            const float g0[2] = {bf2f((bf16_t)(gw & 0xffffu)), bf2f((bf16_t)(gw >> 16))};
            const float u0[2] = {bf2f((bf16_t)(uw & 0xffffu)), bf2f((bf16_t)(uw >> 16))};
            float a[2];
#pragma unroll
            for (int q = 0; q < 2; ++q) {
                const float cg_ = bg[q] + wg[0][q] * g2[q] + wg[1][q] * g1[q] + wg[2][q] * g0[q];
                const float cu_ = bu[q] + wu[0][q] * u2[q] + wu[1][q] * u1[q] + wu[2][q] * u0[q];
                a[q] = cg_ * sigm(cg_) * cu_;
                g2[q] = g1[q]; g1[q] = g0[q]; u2[q] = u1[q]; u1[q] = u0[q];
            }
            *(unsigned*)(rows + (size_t)(lb + q8) * PRIVW + j) = pk2(a[0], a[1]);
        }
    }
}

template <int MT> DI void phaseC(const Params& p, int l, int t, unsigned char* lds) {
    const int row0 = t * 64, d2 = MT == 3 ? tile_d2(t) : 0, tid = otid();
    unsigned char* ws = p.ws;
    bf16_t* priv = (bf16_t*)(ws + OFF_PRIV) + (size_t)row0 * PRIVW;
    bf16_t* xb = (bf16_t*)(ws + OFF_XB) + (size_t)row0 * DM;
    float* x = p.out + (size_t)row0 * DM;
    const float* wc = p.in[25] + (size_t)l * 3 * DFF2;
    const float* bc = p.in[26] + (size_t)l * DFF2;
    __syncthreads();
    for (int jp = tid; jp < DFF / 2; jp += NTHR) {
        const int j = jp * 2;
        float wg[3][2], wu[3][2], bg[2], bu[2];
#pragma unroll
        for (int k = 0; k < 3; ++k) { wg[k][0] = wc[k * DFF2 + j]; wg[k][1] = wc[k * DFF2 + j + 1]; wu[k][0] = wc[k * DFF2 + DFF + j]; wu[k][1] = wc[k * DFF2 + DFF + j + 1]; }
        bg[0] = bc[j]; bg[1] = bc[j + 1]; bu[0] = bc[DFF + j]; bu[1] = bc[DFF + j + 1];
        conv_seg<64>(priv, t > 0 ? (const float*)(ws + OFF_UHALO) + (size_t)(t - 1) * 2 * DFF2 : nullptr, wg, wu, bg, bu, j);
        if (MT == 3) {
            conv_seg<16>(priv + (size_t)(64 + d2) * PRIVW, p.in[9] + ((size_t)l * 8 + 2 * t) * 2 * DFF2, wg, wu, bg, bu, j);
            conv_seg<16>(priv + (size_t)(80 + d2) * PRIVW, p.in[9] + ((size_t)l * 8 + 2 * t + 1) * 2 * DFF2, wg, wu, bg, bu, j);
        }
    }
    gemm64<DFF, MT>(priv, PRIVW, d2, wp(p, l, PW_DOWN), DM / UW, lds, EpiResid<MT>{x, d2});
    __syncthreads();
    if (l == DEPTH - 1) norm_rows<2, MT>(nullptr, nullptr, x, d2, nullptr, p.in[28]);
    else norm_rows<1, MT>(nullptr, nullptr, x, d2, xb, nullptr);
}

DI void pack_layer(const Params& p, int l, int gtid_, int gthreads) {
    int gtid = gtid_; asm volatile("" : "+v"(gtid));
    bf16_t* w = (bf16_t*)(p.ws + OFF_WP) + (size_t)l * PW_LAYER;
    pack_w(p.in[11] + (size_t)l * DM * DIN, p.in[10] + l * DM, DM, DIN, w + PW_IN, 1, gtid, gthreads);
    pack_w(p.in[14] + (size_t)l * 512 * DM, nullptr, 512, DM, w + PW_OA, 0, gtid, gthreads);
    pack_w(p.in[15] + (size_t)l * 512 * DM, nullptr, 512, DM, w + PW_OB, 0, gtid, gthreads);
    pack_w(p.in[16] + (size_t)l * DM * DM, nullptr, DM, DM, w + PW_OUT, 0, gtid, gthreads);
    pack_w(p.in[19] + (size_t)l * DM * 512, p.in[17] + l * DM, DM, 512, w + PW_XQ, 2, gtid, gthreads);
    pack_w(p.in[22] + (size_t)l * 512 * DM, nullptr, 512, DM, w + PW_XO, 0, gtid, gthreads);
    pack_w(p.in[24] + (size_t)l * DM * DFF2, p.in[23] + l * DM, DM, DFF2, w + PW_UP, 0, gtid, gthreads);
    pack_w(p.in[27] + (size_t)l * DFF * DM, nullptr, DFF, DM, w + PW_DOWN, 0, gtid, gthreads);
}

#define XB_TMO      128
#define XB_XCNT(j)  (256  + 64 * (j))
#define XB_XSUB(j)  (1280 + 64 * (j))
#define XB_XGEN(j)  (2304 + 64 * (j))
#define XB_TOP      3328
#define XB_TOPGEN   3392
#define XCD_BAR_WORDS 3456
#define XB_SPIN_CAP (1u << 18)
#define LAS __attribute__((address_space(3)))

__device__ __forceinline__ unsigned xb_ld(unsigned* p)              { return __hip_atomic_load(p, __ATOMIC_RELAXED, __HIP_MEMORY_SCOPE_AGENT); }
__device__ __forceinline__ unsigned xb_add(unsigned* p, unsigned v) { return __hip_atomic_fetch_add(p, v, __ATOMIC_RELAXED, __HIP_MEMORY_SCOPE_AGENT); }
__device__ __forceinline__ unsigned xb_xcc_id() { return (unsigned)__builtin_amdgcn_s_getreg((3 << 11) | 20) & 0xFu; }
#define XB_SPIN(cond, bar) do { unsigned _sp = 0; while (cond) { __builtin_amdgcn_s_sleep(1); \
    if ((++_sp & 255u) == 0u) { if (xb_ld(&(bar)[XB_TMO])) break; if (_sp > XB_SPIN_CAP) { atomicAdd(&(bar)[XB_TMO], 1u); break; } } } } while (0)

struct XcdBarrier {
    unsigned* bar; unsigned x;
    volatile LAS unsigned* st;
};

__device__ __forceinline__ XcdBarrier xcd_barrier_post(unsigned* bar, volatile LAS unsigned* st) {
    XcdBarrier b; b.bar = bar; b.x = xb_xcc_id(); b.st = st;
    if (threadIdx.x == 0) (void)xb_add(&bar[XB_XCNT(b.x)], 1u);
    return b;
}
__device__ __forceinline__ void xcd_barrier_complete(unsigned* bar, unsigned x, unsigned& nloc, unsigned& nx) {
    const unsigned G = gridDim.x * gridDim.y * gridDim.z;
    unsigned sum, cnt, mine, sp = 0u;
    for (;;) {
        sum = 0u; cnt = 0u; mine = 0u;
#pragma unroll
        for (unsigned j = 0; j < 16; ++j) { const unsigned c = xb_ld(&bar[XB_XCNT(j)]); sum += c; cnt += (c > 0u) ? 1u : 0u; mine = (j == x) ? c : mine; }
        if (sum == G) break;
        __builtin_amdgcn_s_sleep(1);
        if ((++sp & 255u) == 0u) { if (xb_ld(&bar[XB_TMO])) break; if (sp > XB_SPIN_CAP) { atomicAdd(&bar[XB_TMO], 1u); break; } }
    }
    nloc = mine > 0u ? mine : 1u; nx = cnt > 0u ? cnt : 1u;
}

__device__ __forceinline__ void xcd_barrier(const XcdBarrier& b) {
    asm volatile("s_waitcnt vmcnt(0)" ::: "memory");
    __syncthreads();
    if (threadIdx.x == 0) {
        unsigned* bar = b.bar;
        __builtin_amdgcn_s_waitcnt(0);
        unsigned nloc = b.st[0], nx = b.st[1];
        if (nloc == 0u) { xcd_barrier_complete(bar, b.x, nloc, nx); b.st[0] = nloc; b.st[1] = nx; }
        const unsigned old = xb_add(&bar[XB_XSUB(b.x)], 1u);
        const unsigned gen = old / nloc;
        if (old + 1u == (gen + 1u) * nloc) {
            __builtin_amdgcn_fence(__ATOMIC_RELEASE, "agent");
            asm volatile("s_waitcnt vmcnt(0)" ::: "memory");
            const unsigned og = xb_add(&bar[XB_TOP], 1u);
            const unsigned tg = og / nx;
            if (og + 1u == (tg + 1u) * nx) xb_add(&bar[XB_TOPGEN], 1u);
            else XB_SPIN(xb_ld(&bar[XB_TOPGEN]) == tg, bar);
            __builtin_amdgcn_fence(__ATOMIC_ACQUIRE, "agent");
            xb_add(&bar[XB_XGEN(b.x)], 1u);
            asm volatile("s_waitcnt vmcnt(0)" ::: "memory");
        } else {
            XB_SPIN(xb_ld(&bar[XB_XGEN(b.x)]) == gen, bar);
            __builtin_amdgcn_fence(__ATOMIC_ACQUIRE, "agent");
            asm volatile("s_waitcnt vmcnt(0)" ::: "memory");
        }
    }
    __syncthreads();
}


__global__ void __launch_bounds__(NTHR) mega(Params p) {
    cg::grid_group grid = cg::this_grid();
    __shared__ __attribute__((aligned(16))) unsigned char lds[LDS_BYTES];
    __shared__ uint4 xb_words;
    if (threadIdx.x == 0) xb_words = make_uint4(0u, 0u, 0u, 0u);
    __syncthreads();
    (void)xcd_barrier_post((unsigned*)(p.ws + OFF_BAR), (volatile LAS unsigned*)&xb_words);
    auto xsync = [&]() { XcdBarrier b; b.bar = (unsigned*)(p.ws + OFF_BAR); b.x = xb_xcc_id(); b.st = (volatile LAS unsigned*)&xb_words; xcd_barrier(b); };
    const int G = gridDim.x, bid = blockIdx.x, tid = threadIdx.x;
    const int gtid = bid * NTHR + tid, gthreads = G * NTHR;
    const int tb = G == NTILE ? (bid & 7) * (NTILE / 8) + (bid >> 3) : bid;
    unsigned char* ws = p.ws;
    pack_layer(p, 0, gtid, gthreads);
    for (int l = 0; l < DEPTH; ++l) {
        pack_w(p.in[20] + (size_t)l * DM * 512, p.in[18] + l * DM, DM, 512, (bf16_t*)(ws + OFF_UHALO) + (size_t)(l * 2 + 0) * 512 * 1024, 0, gtid, gthreads);
        pack_w(p.in[21] + (size_t)l * DM * 512, p.in[18] + l * DM, DM, 512, (bf16_t*)(ws + OFF_UHALO) + (size_t)(l * 2 + 1) * 512 * 1024, 0, gtid, gthreads);
    }
    conv_sample_caches(p, 0, gthreads);
    for (int t = tb; t < NTILE; t += G) {
        const int row0 = t * 64;
        if (t < 4) norm_rows<0, 3>(p.in[0] + (size_t)row0 * DM, p.in[1] + (size_t)(32 * t) * DM, p.out + (size_t)row0 * DM, tile_d2(t), (bf16_t*)(ws + OFF_XB) + (size_t)row0 * DM, nullptr);
    }
    for (int t = tb; t < NTILE; t += G) {
        const int row0 = t * 64;
        if (t >= 4) norm_rows<0, 2>(p.in[0] + (size_t)row0 * DM, p.in[1], p.out + (size_t)row0 * DM, 0, (bf16_t*)(ws + OFF_XB) + (size_t)row0 * DM, nullptr);
    }
    for (int e = tb; e < 8; e += G) if (e >= 4) norm_rows<1, 2>(nullptr, nullptr, (float*)(p.in[2] + (size_t)(e - 4) * 64 * DM), 0, (bf16_t*)(ws + OFF_MEMB) + (size_t)(e - 4) * 64 * DM, nullptr);
    { __syncthreads(); grid.sync(); }
    for (int t = tb; t < NTILE; t += G) if (t < 4) phaseA<3>(p, 0, t, lds);
    for (int t = tb; t < NTILE; t += G) if (t >= 4) phaseA<2>(p, 0, t, lds);
    for (int e = tb; e < 36; e += G) if (e >= 4) mem_kv_unit(p, e - 4, lds);
    xsync();
    for (int l = 0; l < DEPTH; ++l) {
        for (int t = tb; t < NTILE; t += G) if (t < 4) phaseB<3>(p, l, t, lds);
        for (int t = tb; t < NTILE; t += G) if (t >= 4) phaseB<2>(p, l, t, lds);
        if (l + 1 < DEPTH) {
            if (G > 8) { if (tb >= 4) pack_layer(p, l + 1, (tb - 4) * NTHR + otid(), (G - 4) * NTHR); }
            else pack_layer(p, l + 1, bid * NTHR + otid(), G * NTHR);
        }
        xsync();
        if (l + 1 < DEPTH) conv_sample_caches(p, l + 1, gthreads);

        for (int t = tb; t < NTILE; t += G) if (t < 4) { phaseC<3>(p, l, t, lds); if (l + 1 < DEPTH) phaseA<3>(p, l + 1, t, lds); }
        for (int t = tb; t < NTILE; t += G) if (t >= 4) { phaseC<2>(p, l, t, lds); if (l + 1 < DEPTH) phaseA<2>(p, l + 1, t, lds); }
        if (l + 1 < DEPTH) xsync();
    }
}

extern "C" void kernel_launch(void* const* d_in, const int* in_sizes, int n_in, void* d_out, int out_size, void* d_ws, size_t ws_size, hipStream_t stream) {
    static int grid_blocks = 0;
    if (!grid_blocks) {
        int dev = 0, cus = 0, per_cu = 0;
        (void)hipGetDevice(&dev);
        (void)hipDeviceGetAttribute(&cus, hipDeviceAttributeMultiprocessorCount, dev);
        (void)hipOccupancyMaxActiveBlocksPerMultiprocessor(&per_cu, mega, NTHR, 0);
        grid_blocks = cus * per_cu;
        if (grid_blocks > NTILE) grid_blocks = NTILE;
        if (grid_blocks < 1) grid_blocks = 1;
    }
    if (ws_size < WS_TOTAL || n_in < 29) { fprintf(stderr, "workspace too small: %zu < %zu\n", ws_size, (size_t)WS_TOTAL); return; }
    Params p{};
    for (int i = 0; i < 29; ++i) p.in[i] = (const float*)d_in[i];
    p.out = (float*)d_out;
    p.ws = (unsigned char*)d_ws;
    (void)hipMemsetAsync((unsigned char*)d_ws + OFF_BAR, 0, 16384, stream);
    void* args[] = {&p};
    hipError_t e = hipLaunchCooperativeKernel((void*)mega, dim3(grid_blocks), dim3(NTHR), args, 0, stream);
    if (e != hipSuccess) fprintf(stderr, "cooperative launch failed: %s (grid %d)\n", hipGetErrorString(e), grid_blocks);
}
```

```cpp
#include <hip/hip_runtime.h>
#include <hip/hip_cooperative_groups.h>
#include <cstdio>
#include <cstdint>
namespace cg = cooperative_groups;

#define DI __device__ __forceinline__
#ifndef DUP
#define DUP 0
#endif
typedef unsigned short bf16_t;
typedef _Float16 bf16x8 __attribute__((ext_vector_type(8)));
typedef short s16x4 __attribute__((ext_vector_type(4)));
typedef float f32x16 __attribute__((ext_vector_type(16)));
typedef float f32x4 __attribute__((ext_vector_type(4)));
typedef float f32x2 __attribute__((ext_vector_type(2)));
typedef _Float16 bf2_t __attribute__((ext_vector_type(2)));
typedef unsigned u32x4 __attribute__((ext_vector_type(4)));
typedef unsigned u32x2 __attribute__((ext_vector_type(2)));

#define MFMA32(a, b, c) __builtin_amdgcn_mfma_f32_32x32x16_f16((a), (b), (c), 0, 0, 0)

constexpr int DM = 1024, SEQ = 16384, NSMP = 128, MROWS = SEQ + NSMP, NTILE = SEQ / 64, NHALO = MROWS / 64, DEPTH = 4, NTHR = 512, NWAVE = NTHR / 64;
constexpr int DIN = 4352, DFF = 2816, DFF2 = 5632, PRIVW = 5632;
constexpr int PC_QA = 0, PC_QB = 512, PC_GA = 1024, PC_GB = 2048, PC_OA = 3072, PC_OB = 3584, PC_M = 4096, PC_QX = 5120, PC_OX = 0;
constexpr size_t PW_IN = 0, PW_OA = PW_IN + (size_t)DM * DIN, PW_OB = PW_OA + 512 * 1024, PW_OUT = PW_OB + 512 * 1024,
                 PW_XQ = PW_OUT + 1024 * 1024, PW_XO = PW_XQ + 1024 * 512, PW_UP = PW_XO + 512 * 1024,
                 PW_DOWN = PW_UP + (size_t)DM * DFF2, PW_LAYER = PW_DOWN + (size_t)DFF * DM;
constexpr size_t OFF_WP = 0;
constexpr size_t OFF_XB = OFF_WP + PW_LAYER * 2 * DEPTH;
constexpr size_t OFF_PRIV = OFF_XB + (size_t)MROWS * DM * 2;
constexpr size_t OFF_KA = OFF_PRIV + (size_t)MROWS * PRIVW * 2;
constexpr size_t OFF_VTA = OFF_KA + (size_t)MROWS * 128 * 2;
constexpr size_t OFF_KB = OFF_VTA + (size_t)MROWS * 128 * 2;
constexpr size_t OFF_VTB = OFF_KB + (size_t)MROWS * 512 * 2;
constexpr size_t OFF_UHALO = OFF_VTB + (size_t)MROWS * 512 * 2;
constexpr size_t OFF_MEMB = OFF_UHALO + (size_t)NHALO * 2 * DFF2 * 4;
constexpr size_t OFF_MK = OFF_MEMB + 256 * 1024 * 2;
constexpr size_t OFF_MVT = OFF_MK + (size_t)DEPTH * 256 * 512 * 2;
constexpr size_t OFF_SKA = OFF_MVT + (size_t)DEPTH * 256 * 512 * 2;
constexpr size_t OFF_SVTA = OFF_SKA + 8 * 128 * 128 * 2;
constexpr size_t OFF_SKB = OFF_SVTA + 8 * 128 * 128 * 2;
constexpr size_t OFF_SVTB = OFF_SKB + 8 * 512 * 512 * 2;
constexpr size_t OFF_SMK = OFF_SVTB + 8 * 512 * 512 * 2;
constexpr size_t OFF_SMVT = OFF_SMK + 8 * 256 * 512 * 2;
constexpr size_t OFF_BAR = OFF_SMVT + 8 * 256 * 512 * 2;
constexpr size_t WS_TOTAL = OFF_BAR + 16384;
constexpr size_t O_Y = 0, O_PAK = (size_t)MROWS * DM, O_PAV = O_PAK + 4 * 128 * 128, O_PBK = O_PAV + 4 * 128 * 128, O_PBV = O_PBK + 4 * 512 * 512,
                 O_PMK = O_PBV + 4 * 512 * 512, O_PMV = O_PMK + 4 * 256 * 512, O_PCONV = O_PMV + 4 * 256 * 512, O_SAK = O_PCONV + 4 * 2 * DFF2,
                 O_SAV = O_SAK + 4 * 128 * 128, O_SBK = O_SAV + 4 * 128 * 128, O_SBV = O_SBK + 4 * 128 * 512, O_SCONV = O_SBV + 4 * 128 * 512;

constexpr int A_CHUNK = 128, A_LD = A_CHUNK * 2 + 16, A_BUF = 96 * A_LD;
constexpr int ARES_LD = 1024 * 2 + 16;
constexpr int LDS_BYTES = 64 * ARES_LD > 2 * A_BUF ? 64 * ARES_LD : 2 * A_BUF;
constexpr float LOG2E = 1.4426950408889634f;
constexpr int NT = 2, UW = NT * 32;

struct Params {
    const float* in[29];
    float* out;
    unsigned char* ws;
};

DI void lds_barrier() { asm volatile("s_waitcnt lgkmcnt(0)\n\ts_barrier" ::: "memory"); }
DI int otid() { int t = threadIdx.x; asm volatile("" : "+v"(t)); return t; }
DI unsigned pk2(float lo, float hi) { f32x2 v = {lo, hi}; bf2_t b = __builtin_convertvector(v, bf2_t); return __builtin_bit_cast(unsigned, b); }
DI bf16_t cv1(float x) { return (bf16_t)(pk2(x, 0.f) & 0xffffu); }
DI float bf2f(bf16_t v) { return (float)__builtin_bit_cast(_Float16, v); }
DI int crow(int i, int h) { return (i & 3) + 8 * (i >> 2) + 4 * h; }
DI float sigm(float x) { return 1.f / (1.f + __expf(-x)); }

DI void pack_w(const float* __restrict__ W, const float* __restrict__ g, int K, int N, bf16_t* dst, int mode, int gtid, int gthreads) {
    const int KS = K / 16, NTt = N / 32, total = NTt * KS * 16;
    for (int idx = gtid; idx < total; idx += gthreads) {
        const int rq = idx & 7, h = (idx >> 3) & 1, blk = idx >> 4, nt = blk % NTt, ks = blk / NTt;
        const int n = nt * 32 + 4 * rq, k0 = ks * 16 + 8 * h;
        float sc = 1.f;
        if (mode == 1) { if (n < 512 || (n >= 768 && n < 1280)) sc = 0.125f; }
        else if (mode == 2) sc = 0.08838834764831845f;
        f32x4 v[8];
#pragma unroll
        for (int j = 0; j < 8; ++j) v[j] = *(const f32x4*)(W + (size_t)(k0 + j) * N + n) * ((g ? g[k0 + j] : 1.f) * sc);
        u32x4* o = (u32x4*)dst + (size_t)blk * 64 + h * 32 + 4 * rq;
#pragma unroll
        for (int e = 0; e < 4; ++e) { u32x4 w = {pk2(v[0][e], v[1][e]), pk2(v[2][e], v[3][e]), pk2(v[4][e], v[5][e]), pk2(v[6][e], v[7][e])}; o[e] = w; }
    }
}
DI void conv_kp(const float* __restrict__ src, bf16_t* dst, int B, int R, int H, int HD, int gtid, int gthreads) {
    const int C = H * HD, C8 = C / 8, KSQ = HD / 16, total = B * R * C8;
    for (int idx = gtid; idx < total; idx += gthreads) {
        const int c8 = idx % C8, t2 = idx / C8, t = t2 % R, b = t2 / R;
        const f32x4* sp = (const f32x4*)(src + ((size_t)b * R + t) * C + c8 * 8);
        const f32x4 v0 = sp[0], v1 = sp[1];
        const int col = c8 * 8, hd = col / HD, d = col % HD;
        const size_t o16 = ((((size_t)b * (R / 32) + (t >> 5)) * H + hd) * KSQ + (d >> 4)) * 64 + (t & 31) + 32 * ((d >> 3) & 1);
        u32x4 w = {pk2(v0[0], v0[1]), pk2(v0[2], v0[3]), pk2(v1[0], v1[1]), pk2(v1[2], v1[3])};
        ((u32x4*)dst)[o16] = w;
    }
}
DI void conv_vp(const float* __restrict__ src, bf16_t* dst, int B, int R, int C, int gtid, int gthreads) {
    const int DTt = C / 32, total = B * (R / 16) * DTt * 64;
    for (int idx = gtid; idx < total; idx += gthreads) {
        const int lane = idx & 63, f = idx >> 6, sp_ = f & 1, f2 = f >> 1, dd = f2 % DTt, f3 = f2 / DTt, tb = f3 % (R / 32), b = f3 / (R / 32);
        const int r = lane & 31, h = lane >> 5;
        const float* s0 = src + ((size_t)b * R + 32 * tb + 16 * sp_ + 4 * h) * C + dd * 32 + r;
        float v[8];
#pragma unroll
        for (int j = 0; j < 8; ++j) v[j] = s0[(size_t)(8 * (j >> 2) + (j & 3)) * C];
        u32x4 w = {pk2(v[0], v[1]), pk2(v[2], v[3]), pk2(v[4], v[5]), pk2(v[6], v[7])};
        ((u32x4*)dst)[idx] = w;
    }
}
DI void conv_sample_caches(const Params& p, int l, int gthreads) {
    unsigned char* ws = p.ws;
    const int gtid = blockIdx.x * NTHR + otid();
    conv_kp(p.in[3] + (size_t)l * 8 * 128 * 128, (bf16_t*)(ws + OFF_SKA), 8, 128, 2, 64, gtid, gthreads);
    conv_vp(p.in[4] + (size_t)l * 8 * 128 * 128, (bf16_t*)(ws + OFF_SVTA), 8, 128, 128, gtid, gthreads);
    conv_kp(p.in[5] + (size_t)l * 8 * 512 * 512, (bf16_t*)(ws + OFF_SKB), 8, 512, 8, 64, gtid, gthreads);
    conv_vp(p.in[6] + (size_t)l * 8 * 512 * 512, (bf16_t*)(ws + OFF_SVTB), 8, 512, 512, gtid, gthreads);
    conv_kp(p.in[7] + (size_t)l * 8 * 256 * 512, (bf16_t*)(ws + OFF_SMK), 8, 256, 4, 128, gtid, gthreads);
    conv_vp(p.in[8] + (size_t)l * 8 * 256 * 512, (bf16_t*)(ws + OFF_SMVT), 8, 256, 512, gtid, gthreads);
}
template <int MODE, int MT> DI void norm_rows(const float* src, const float* src2, float* x, int d2, bf16_t* xb, const float* __restrict__ g) {
    const int tid_ = otid(), wave = tid_ >> 6, lane = tid_ & 63;
    for (int rb = 0; rb < MT; ++rb) {
        f32x4 v[4][4]; float ss[4];
#pragma unroll
        for (int q = 0; q < 4; ++q) {
            const int row = wave * (MT * 4) + rb * 4 + q, grow = row + (row >= 64 ? d2 : 0);
            const float* s = x + (size_t)grow * DM;
            if (MODE == 0) { s = src + (size_t)row * DM; if (MT == 3 && row >= 64) s = src2 + (size_t)(row - 64) * DM; }
            ss[q] = 0.f;
#pragma unroll
            for (int i = 0; i < 4; ++i) { v[q][i] = *(const f32x4*)(s + i * 256 + lane * 4); ss[q] += v[q][i][0] * v[q][i][0] + v[q][i][1] * v[q][i][1] + v[q][i][2] * v[q][i][2] + v[q][i][3] * v[q][i][3]; }
        }
#pragma unroll
        for (int o = 32; o >= 1; o >>= 1)
#pragma unroll
            for (int q = 0; q < 4; ++q) ss[q] += __shfl_xor(ss[q], o);
#pragma unroll
        for (int q = 0; q < 4; ++q) {
            const int row = wave * (MT * 4) + rb * 4 + q, grow = row + (row >= 64 ? d2 : 0);
            const float rstd = rsqrtf(ss[q] * (1.f / DM) + 1e-6f);
#pragma unroll
            for (int i = 0; i < 4; ++i) {
                if (MODE == 0) *(f32x4*)(x + (size_t)grow * DM + i * 256 + lane * 4) = v[q][i];
                if (MODE == 2) { f32x4 gg = *(const f32x4*)(g + i * 256 + lane * 4); *(f32x4*)(x + (size_t)grow * DM + i * 256 + lane * 4) = v[q][i] * rstd * gg; }
                else { u32x2 o = {pk2(v[q][i][0] * rstd, v[q][i][1] * rstd), pk2(v[q][i][2] * rstd, v[q][i][3] * rstd)}; *(u32x2*)(xb + (size_t)grow * DM + i * 256 + lane * 4) = o; }
            }
        }
    }
}

struct EpiNull { float* sink;
    template <int MT> DI void operator()(int, const f32x16 (&acc)[MT][NT]) const {
        float s = 0.f;
#pragma unroll
        for (int mi = 0; mi < MT; ++mi)
#pragma unroll
            for (int nj = 0; nj < NT; ++nj)
#pragma unroll
                for (int i = 0; i < 16; ++i) s += acc[mi][nj][i];
        if (s == 1.2345e30f) *sink = s;
    } };
template <int K, class Epi>
DI void gemm64_res(const bf16_t* A, int lda, const bf16_t* Wp, int NU, unsigned char* lds, const Epi& epi) {
    constexpr int KS = K / 16, PD = 4, LD = K * 2 + 16, SEGS = K / 8, NIT = 64 * SEGS / NTHR;
    const int tid = otid(), wave = __builtin_amdgcn_readfirstlane(tid >> 6), lane = tid & 63, r = lane & 31, h = lane >> 5;
    const u32x4* Bw = (const u32x4*)Wp;
    const size_t kstr = (size_t)NU * NT * 64;
    const int rot = ((blockIdx.x >> 3) * (KS / 32)) & (KS - 1);
    __syncthreads();
#pragma unroll
    for (int i0 = 0; i0 < NIT; i0 += 8) {
        u32x4 t8[8];
#pragma unroll
        for (int i = 0; i < 8; ++i) { const int idx = (i0 + i) * NTHR + tid, row = idx / SEGS, seg = idx % SEGS; t8[i] = *(const u32x4*)(A + (row * lda + seg * 8)); }
#pragma unroll
        for (int i = 0; i < 8; ++i) { const int idx = (i0 + i) * NTHR + tid, row = idx / SEGS, seg = idx % SEGS; *(u32x4*)(lds + row * LD + seg * 16) = t8[i]; }
    }
    __syncthreads();
    const unsigned char* ab = lds + r * LD + 16 * h;
#pragma unroll 1
    for (int unit = wave; unit < NU; unit += NWAVE) {
        const u32x4* bp = Bw + (size_t)(unit * NT) * 64 + lane;
        f32x16 acc[2][NT];
#pragma unroll
        for (int mi = 0; mi < 2; ++mi)
#pragma unroll
            for (int nj = 0; nj < NT; ++nj)
#pragma unroll
                for (int i = 0; i < 16; ++i) acc[mi][nj][i] = 0.f;
        u32x4 bq[PD][NT];
#pragma unroll
        for (int s = 0; s < PD; ++s)
#pragma unroll
            for (int j = 0; j < NT; ++j) bq[s][j] = bp[(size_t)((s + rot) & (KS - 1)) * kstr + j * 64];
#pragma unroll 1
        for (int kk = 0; kk < KS; kk += PD) {
#pragma unroll
            for (int s = 0; s < PD; ++s) {
                const int ks = kk + s, ksr = (ks + rot) & (KS - 1);
                const bf16x8 a0 = *(const bf16x8*)(ab + ksr * 32), a1 = *(const bf16x8*)(ab + 32 * LD + ksr * 32);
#pragma unroll
                for (int j = 0; j < NT; ++j) { acc[0][j] = MFMA32(a0, __builtin_bit_cast(bf16x8, bq[s][j]), acc[0][j]); acc[1][j] = MFMA32(a1, __builtin_bit_cast(bf16x8, bq[s][j]), acc[1][j]); }
                int nk = ks + PD; nk = nk < KS ? nk : KS - 1; nk = (nk + rot) & (KS - 1);
#pragma unroll
                for (int j = 0; j < NT; ++j) bq[s][j] = bp[(size_t)nk * kstr + j * 64];
                __builtin_amdgcn_sched_barrier(0);
            }
        }
        epi(unit, acc);
    }
}

template <int K, int MT, class Epi, int XM = 0>
DI void gemm64(const bf16_t* A, int lda, int d2, const bf16_t* Wp, int NU, unsigned char* lds, const Epi& epi) {
    if constexpr (MT == 2 && K <= 1024 && XM == 0) { gemm64_res<K>(A, lda, Wp, NU, lds, epi); return; }
    constexpr int KS = K / 16, NCH = K / A_CHUNK, PD = 4;
    const int tid = otid(), wave = tid >> 6, lane = tid & 63, r = lane & 31, h = lane >> 5;
    const u32x4* Bw = (const u32x4*)Wp;
#pragma unroll 1
    for (int pass = 0; pass * NWAVE < NU; ++pass) {
        const int unit = pass * NWAVE + wave;
        const bool active = unit < NU;
        const int ucl = active ? unit : NU - 1;
        const u32x4* bp = Bw + (size_t)(ucl * NT) * 64 + lane;
        const size_t kstr = (size_t)NU * NT * 64;
        f32x16 acc[MT][NT];
#pragma unroll
        for (int mi = 0; mi < MT; ++mi)
#pragma unroll
            for (int nj = 0; nj < NT; ++nj)
#pragma unroll
                for (int i = 0; i < 16; ++i) acc[mi][nj][i] = 0.f;
        u32x4 bq[PD][NT];
#pragma unroll
        for (int s = 0; s < PD; ++s)
#pragma unroll
            for (int j = 0; j < NT; ++j) bq[s][j] = bp[(size_t)s * kstr + j * 64];
        u32x4 areg[MT];
        if (pass == 0) __syncthreads();
#pragma unroll
        for (int i = 0; i < MT; ++i) { const int idx = i * NTHR + tid, row = idx >> 4, seg = idx & 15; areg[i] = *(const u32x4*)(A + ((row + (i == 2 ? d2 : 0)) * lda + seg * 8)); }
#pragma unroll
        for (int i = 0; i < MT; ++i) { const int idx = i * NTHR + tid, row = idx >> 4, seg = idx & 15; *(u32x4*)(lds + row * A_LD + seg * 16) = areg[i]; }
        lds_barrier();
#pragma unroll 1
        for (int c = 0; c < NCH; ++c) {
            if (c + 1 < NCH) {
#pragma unroll
                for (int i = 0; i < MT; ++i) { const int idx = i * NTHR + tid, row = idx >> 4, seg = idx & 15; areg[i] = *(const u32x4*)(A + ((row + (i == 2 ? d2 : 0)) * lda + (c + 1) * A_CHUNK + seg * 8)); }
            }
            const unsigned char* ab = lds + (c & 1) * A_BUF + r * A_LD + 16 * h;
            if (active) {
                bf16x8 a[MT], n[MT];
#pragma unroll
                for (int mi = 0; mi < MT; ++mi) a[mi] = *(const bf16x8*)(ab + mi * 32 * A_LD);
#pragma unroll
                for (int ks = 0; ks < A_CHUNK / 16; ++ks) {
#pragma unroll
                    for (int mi = 0; mi < MT; ++mi) n[mi] = a[mi];
                    if (ks + 1 < A_CHUNK / 16) {
#pragma unroll
                        for (int mi = 0; mi < MT; ++mi) n[mi] = *(const bf16x8*)(ab + mi * 32 * A_LD + (ks + 1) * 32);
                    }
#pragma unroll
                    for (int j = 0; j < NT; ++j)
#pragma unroll
                        for (int mi = 0; mi < MT; ++mi) acc[mi][j] = MFMA32(a[mi], __builtin_bit_cast(bf16x8, bq[ks % PD][j]), acc[mi][j]);
                    int nk = c * (A_CHUNK / 16) + ks + PD; nk = nk < KS ? nk : KS - 1;
#pragma unroll
                    for (int j = 0; j < NT; ++j) { if (XM == 0) bq[ks % PD][j] = bp[(size_t)nk * kstr + j * 64]; else if (XM == 1) bq[ks % PD][j] = bp[(size_t)(nk & 7) * 128 + j * 64]; }
                    __builtin_amdgcn_sched_barrier(0);
#pragma unroll
                    for (int mi = 0; mi < MT; ++mi) a[mi] = n[mi];
                }
            }
            if (c + 1 < NCH) {
                unsigned char* wb = lds + ((c + 1) & 1) * A_BUF;
#pragma unroll
                for (int i = 0; i < MT; ++i) { const int idx = i * NTHR + tid, row = idx >> 4, seg = idx & 15; *(u32x4*)(wb + row * A_LD + seg * 16) = areg[i]; }
            }
            lds_barrier();
        }
        if (active) epi(unit, acc);
    }
}

template <int MT> DI void st_bf16(bf16_t* base, int ld, int d2, int col0, const f32x16 (&acc)[MT][NT]) {
    const int lane = otid() & 63, r = lane & 31, h = lane >> 5;
#pragma unroll
    for (int mi = 0; mi < MT; ++mi)
#pragma unroll
        for (int nj = 0; nj < NT; ++nj)
#pragma unroll
            for (int i = 0; i < 16; ++i) base[(mi * 32 + crow(i, h) + (mi == 2 ? d2 : 0)) * ld + col0 + nj * 32 + r] = cv1(acc[mi][nj][i]);
}
template <int MI0, int MI1, int MT> DI void st_f32(float* base, int ld, int col0, const f32x16 (&acc)[MT][NT]) {
    const int lane = otid() & 63, r = lane & 31, h = lane >> 5;
#pragma unroll
    for (int mi = MI0; mi < MI1; ++mi)
#pragma unroll
        for (int nj = 0; nj < NT; ++nj)
#pragma unroll
            for (int i = 0; i < 16; ++i) base[((mi - MI0) * 32 + crow(i, h)) * ld + col0 + nj * 32 + r] = acc[mi][nj][i];
}
template <int MT> DI void st_kp(bf16_t* kp, int H, int KSQ, int hd, int dbase, int tb0, int tb2, const f32x16 (&acc)[MT][NT]) {
    const int lane = otid() & 63, r = lane & 31, h = lane >> 5;
#pragma unroll
    for (int mi = 0; mi < MT; ++mi)
#pragma unroll
        for (int nj = 0; nj < NT; ++nj) {
            const int tb = mi == 2 ? tb2 : tb0 + mi, d = dbase + nj * 32 + r;
            bf16_t* fp = kp + ((tb * H + hd) * KSQ + (d >> 4)) * 512 + 32 * ((d >> 3) & 1) * 8 + (d & 7);
#pragma unroll
            for (int i = 0; i < 16; ++i) fp[crow(i, h) * 8] = cv1(acc[mi][nj][i]);
        }
}
template <int MT> DI void st_vp(bf16_t* vp, int DTt, int dd0, int tb0, int tb2, const f32x16 (&acc)[MT][NT]) {
    const int lane = otid() & 63;
#pragma unroll
    for (int mi = 0; mi < MT; ++mi)
#pragma unroll
        for (int nj = 0; nj < NT; ++nj)
#pragma unroll
            for (int sp_ = 0; sp_ < 2; ++sp_) {
                const int tb = mi == 2 ? tb2 : tb0 + mi;
                u32x4 w = {pk2(acc[mi][nj][8 * sp_], acc[mi][nj][8 * sp_ + 1]), pk2(acc[mi][nj][8 * sp_ + 2], acc[mi][nj][8 * sp_ + 3]),
                           pk2(acc[mi][nj][8 * sp_ + 4], acc[mi][nj][8 * sp_ + 5]), pk2(acc[mi][nj][8 * sp_ + 6], acc[mi][nj][8 * sp_ + 7])};
                *(u32x4*)(vp + ((((tb * DTt + dd0 + nj) * 2 + sp_) * 64 + lane) * 8)) = w;
            }
}

template <int MT> struct EpiMixIn {
    bf16_t* priv; bf16_t *ka, *kb, *vta, *vtb; int d2, tb0, tb2;
    float *oak, *oav, *obk, *obv;
    float *sak, *sav, *sbk, *sbv;
    DI void operator()(int unit, const f32x16 (&acc)[MT][NT]) const {
        if (unit < 8) st_bf16<MT>(priv, PRIVW, d2, PC_QA + unit * UW, acc);
        else if (unit < 10) { st_kp<MT>(ka, 2, 4, unit - 8, 0, tb0, tb2, acc); if (oak) st_f32<0, 2, MT>(oak, 128, (unit - 8) * UW, acc); if (MT == 3) st_f32<2, MT, MT>(sak, 128, (unit - 8) * UW, acc); }
        else if (unit < 12) { st_vp<MT>(vta, 4, (unit - 10) * 2, tb0, tb2, acc); if (oav) st_f32<0, 2, MT>(oav, 128, (unit - 10) * UW, acc); if (MT == 3) st_f32<2, MT, MT>(sav, 128, (unit - 10) * UW, acc); }
        else if (unit < 20) st_bf16<MT>(priv, PRIVW, d2, PC_QB + (unit - 12) * UW, acc);
        else if (unit < 28) { st_kp<MT>(kb, 8, 4, unit - 20, 0, tb0, tb2, acc); if (obk) st_f32<0, 2, MT>(obk, 512, (unit - 20) * UW, acc); if (MT == 3) st_f32<2, MT, MT>(sbk, 512, (unit - 20) * UW, acc); }
        else if (unit < 36) { st_vp<MT>(vtb, 16, (unit - 28) * 2, tb0, tb2, acc); if (obv) st_f32<0, 2, MT>(obv, 512, (unit - 28) * UW, acc); if (MT == 3) st_f32<2, MT, MT>(sbv, 512, (unit - 28) * UW, acc); }
        else {
            const int lane = otid() & 63, r = lane & 31, h = lane >> 5;
            const int col0 = PC_GA + (unit - 36) * UW;
#pragma unroll
            for (int mi = 0; mi < MT; ++mi)
#pragma unroll
                for (int nj = 0; nj < NT; ++nj)
#pragma unroll
                    for (int i = 0; i < 16; ++i) priv[(mi * 32 + crow(i, h) + (mi == 2 ? d2 : 0)) * PRIVW + col0 + nj * 32 + r] = cv1(sigm(acc[mi][nj][i]));
        }
    }
};
template <int MT, int SECOND> struct EpiGate {
    bf16_t* priv; int gcol; int d2;
    DI void operator()(int unit, const f32x16 (&acc)[MT][NT]) const {
        const int lane = otid() & 63, r = lane & 31, h = lane >> 5;
#pragma unroll
        for (int mi = 0; mi < MT; ++mi)
#pragma unroll
            for (int nj = 0; nj < NT; ++nj)
#pragma unroll
                for (int i = 0; i < 16; ++i) {
                    bf16_t* rowp = priv + (mi * 32 + crow(i, h) + (mi == 2 ? d2 : 0)) * PRIVW; const int c = unit * UW + nj * 32 + r;
                    float v = bf2f(rowp[gcol + c]) * acc[mi][nj][i];
                    if (SECOND) v += bf2f(rowp[PC_M + c]);
                    rowp[PC_M + c] = cv1(v);
                    if (i == 15) __builtin_amdgcn_sched_barrier(0);
                }
    }
};
template <int MT> struct EpiResid {
    float* x; int d2;
    DI void operator()(int unit, const f32x16 (&acc)[MT][NT]) const {
        const int lane = otid() & 63, r = lane & 31, h = lane >> 5;
#pragma unroll
        for (int mi = 0; mi < MT; ++mi)
#pragma unroll
            for (int nj = 0; nj < NT; ++nj)
#pragma unroll
                for (int i = 0; i < 16; ++i) { float* q = x + ((mi * 32 + crow(i, h) + (mi == 2 ? d2 : 0)) * DM + unit * UW + nj * 32 + r); *q = *q + acc[mi][nj][i]; if (i == 15) __builtin_amdgcn_sched_barrier(0); }
    }
};
template <int MT> struct EpiStore { bf16_t* base; int ld; int col0; int d2;
    DI void operator()(int unit, const f32x16 (&acc)[MT][NT]) const { st_bf16<MT>(base, ld, d2, col0 + unit * UW, acc); } };
template <int MT> struct EpiUp {
    bf16_t* priv; float* halo; float* pconv; float* sconv; int d2;
    DI void operator()(int unit, const f32x16 (&acc)[MT][NT]) const {
        st_bf16<MT>(priv, PRIVW, d2, unit * UW, acc);
        const int lane = otid() & 63, r = lane & 31, h = lane >> 5;
#pragma unroll
        for (int mi = 1; mi < MT; ++mi)
#pragma unroll
            for (int nj = 0; nj < NT; ++nj)
#pragma unroll
                for (int i = 0; i < 16; ++i) {
                    const int lr = mi * 32 + crow(i, h), c = unit * UW + nj * 32 + r;
                    if (mi == 1) { if (lr >= 62) { halo[(lr - 62) * DFF2 + c] = acc[mi][nj][i]; if (pconv) pconv[(lr - 62) * DFF2 + c] = acc[mi][nj][i]; } }
                    else if ((lr & 15) >= 14) sconv[(((lr - 64) >> 4) * 2 + ((lr & 15) - 14)) * DFF2 + c] = acc[mi][nj][i];
                }
    }
};
struct EpiMemKV { bf16_t* kp; bf16_t* vp; float* o; int isv; int tb0;
    DI void operator()(int unit, const f32x16 (&acc)[2][NT]) const {
        if (isv) st_vp<2>(vp, 16, unit * 2, tb0, 0, acc); else st_kp<2>(kp, 4, 8, unit >> 1, (unit & 1) * 64, tb0, 0, acc);
        st_f32<0, 2, 2>(o, 512, unit * UW, acc);
    } };

template <int HD, int BIAS, bool FULL>
DI void attn_block(const bf16_t* Kb, int ktb, const bf16_t* Vb, int vtb, int koff, int kpos0, int qp, float slope, const float* rel,
                   const bf16x8 (&qf)[HD / 16], f32x16 (&o)[HD / 32], float& m, float& l) {
    constexpr int KSQ = HD / 16, DT = HD / 32, NKT = FULL ? 2 : 1;
    constexpr bool VTOP = HD == 64;
    const int lane = otid() & 63, h = lane >> 5;
    const int kbeg = FULL ? 0 : koff, kend = FULL ? 64 : koff + 16;
    const int s0 = FULL ? 0 : (koff >> 4);
    int dq = kpos0 + 4 * h - qp; asm volatile("" : "+v"(dq));
    bf16x8 kreg[NKT][KSQ];
#pragma unroll
    for (int kt = 0; kt < NKT; ++kt)
#pragma unroll
        for (int ks = 0; ks < KSQ; ++ks) kreg[kt][ks] = *(const bf16x8*)(Kb + (size_t)kt * ktb + ks * 512 + lane * 8);
    constexpr int NS = FULL ? 4 : 1;
    bf16x8 vreg[DT][NS];
    auto loadV = [&]() {
#pragma unroll
        for (int si = 0; si < NS; ++si)
#pragma unroll
            for (int dt = 0; dt < DT; ++dt) { const int s = FULL ? si : s0; vreg[dt][si] = *(const bf16x8*)(Vb + (size_t)(s >> 1) * vtb + dt * 1024 + (s & 1) * 512 + lane * 8); }
    };
    if (VTOP) loadV();
    __builtin_amdgcn_sched_barrier(0);
    f32x16 st[NKT];
#pragma unroll
    for (int kt = 0; kt < NKT; ++kt) {
#pragma unroll
        for (int i = 0; i < 16; ++i) st[kt][i] = 0.f;
#pragma unroll
        for (int ks = 0; ks < KSQ; ++ks) st[kt] = MFMA32(kreg[kt][ks], qf[ks], st[kt]);
    }
    __builtin_amdgcn_sched_barrier(0);
    if (!VTOP) loadV();
    float mx = -1e30f;
#pragma unroll
    for (int kt = 0; kt < NKT; ++kt)
#pragma unroll
        for (int i = 0; i < 16; ++i) {
            const int key = kt * 32 + crow(i, h);
            float s = st[kt][i];
            const int dk = dq + (kt * 32 + (i & 3) + 8 * (i >> 2));
            if (BIAS == 1) s -= slope * (float)(dk < 0 ? -dk : dk);
            if (BIAS == 2) { int d = dk < -256 ? -256 : (dk > 256 ? 256 : dk); s += rel[d + 256]; }
            if (!FULL) { if (key < kbeg || key >= kend) s = -1e30f; }
            st[kt][i] = s; mx = fmaxf(mx, s);
        }
    mx = fmaxf(mx, __shfl_xor(mx, 32));
    const float mn = fmaxf(m, mx);
    const float alpha = __builtin_amdgcn_exp2f((m - mn) * LOG2E);
    m = mn;
    float ps = 0.f;
#pragma unroll
    for (int kt = 0; kt < NKT; ++kt)
#pragma unroll
        for (int i = 0; i < 16; ++i) { const float pv = __builtin_amdgcn_exp2f((st[kt][i] - mn) * LOG2E); st[kt][i] = pv; ps += pv; }
    l = l * alpha + ps;
#pragma unroll
    for (int dt = 0; dt < DT; ++dt)
#pragma unroll
        for (int i = 0; i < 16; ++i) o[dt][i] *= alpha;
#pragma unroll
    for (int si = 0; si < NS; ++si) {
        u32x4 pw;
        if (FULL) { const int kt = si >> 1, b0 = (si & 1) * 8; pw = (u32x4){pk2(st[kt][b0], st[kt][b0 + 1]), pk2(st[kt][b0 + 2], st[kt][b0 + 3]), pk2(st[kt][b0 + 4], st[kt][b0 + 5]), pk2(st[kt][b0 + 6], st[kt][b0 + 7])}; }
        else {
            const u32x4 lo = {pk2(st[0][0], st[0][1]), pk2(st[0][2], st[0][3]), pk2(st[0][4], st[0][5]), pk2(st[0][6], st[0][7])};
            const u32x4 hi = {pk2(st[0][8], st[0][9]), pk2(st[0][10], st[0][11]), pk2(st[0][12], st[0][13]), pk2(st[0][14], st[0][15])};
            pw = (s0 & 1) ? hi : lo;
        }
        const bf16x8 pf = __builtin_bit_cast(bf16x8, pw);
#pragma unroll
        for (int dt = 0; dt < DT; ++dt) o[dt] = MFMA32(vreg[dt][si], pf, o[dt]);
    }
}

template <int HD, int BIAS>
DI void attn_item(const bf16_t* Q, int qstride, int nq, int qpos0,
                  const bf16_t* K1, int ktb1, const bf16_t* V1, int vtb1, int nb1, int pos1,
                  const bf16_t* K2, const bf16_t* V2, int nb2, int pos2, int koff2,
                  float m0, float l0, float slope, const float* rel, bf16_t* O, int ostride) {
    constexpr int KSQ = HD / 16, DT = HD / 32;
    const int lane = otid() & 63, r = lane & 31, h = lane >> 5;
    const int qr = r < nq ? r : nq - 1;
    bf16x8 qf[KSQ];
#pragma unroll
    for (int ks = 0; ks < KSQ; ++ks) qf[ks] = *(const bf16x8*)(Q + (size_t)qr * qstride + ks * 16 + 8 * h);
    f32x16 o[DT];
#pragma unroll
    for (int dt = 0; dt < DT; ++dt)
#pragma unroll
        for (int i = 0; i < 16; ++i) o[dt][i] = 0.f;
    float m = m0, l = h == 0 ? l0 : 0.f;
    const int qp = qpos0 + qr;
#pragma unroll 1
    for (int blk = 0; blk < nb1; ++blk)
        attn_block<HD, BIAS, true>(K1 + (size_t)(2 * blk) * ktb1, ktb1, V1 + (size_t)(2 * blk) * vtb1, vtb1, 0, pos1 + blk * 64, qp, slope, rel, qf, o, m, l);
    if (nb2) attn_block<HD, BIAS, false>(K2, 0, V2, 0, koff2, pos2 - koff2, qp, slope, rel, qf, o, m, l);
    const float lt = l + __shfl_xor(l, 32);
    const float inv = 1.f / lt;
    if (r < nq) {
#pragma unroll
        for (int dt = 0; dt < DT; ++dt)
#pragma unroll
            for (int g = 0; g < 4; ++g) {
                u32x2 w = {pk2(o[dt][4 * g] * inv, o[dt][4 * g + 1] * inv), pk2(o[dt][4 * g + 2] * inv, o[dt][4 * g + 3] * inv)};
                *(u32x2*)(O + (size_t)r * ostride + dt * 32 + 8 * g + 4 * h) = w;
            }
    }
}

DI const bf16_t* wp(const Params& p, int l, size_t off) { return (const bf16_t*)(p.ws + OFF_WP) + (size_t)l * PW_LAYER + off; }
DI int tile_d2(int t) { return SEQ + 32 * t - (64 * t + 64); }

template <int MT> DI void phaseA(const Params& p, int l, int t, unsigned char* lds) {
    const int row0 = t * 64, d2 = MT == 3 ? tile_d2(t) : 0;
    unsigned char* ws = p.ws;
    EpiMixIn<MT> e;
    e.priv = (bf16_t*)(ws + OFF_PRIV) + (size_t)row0 * PRIVW;
    e.ka = (bf16_t*)(ws + OFF_KA); e.kb = (bf16_t*)(ws + OFF_KB); e.vta = (bf16_t*)(ws + OFF_VTA); e.vtb = (bf16_t*)(ws + OFF_VTB);
    e.tb0 = 2 * t; e.tb2 = SEQ / 32 + t;
    e.d2 = d2;
    e.oak = e.oav = e.obk = e.obv = nullptr;
    e.sak = e.sav = e.sbk = e.sbv = nullptr;
    if (row0 >= SEQ - 128) { const int pr = row0 - (SEQ - 128); e.oak = p.out + O_PAK + (size_t)l * 128 * 128 + (size_t)pr * 128; e.oav = p.out + O_PAV + (size_t)l * 128 * 128 + (size_t)pr * 128; }
    if (row0 >= SEQ - 512) { const int pr = row0 - (SEQ - 512); e.obk = p.out + O_PBK + (size_t)l * 512 * 512 + (size_t)pr * 512; e.obv = p.out + O_PBV + (size_t)l * 512 * 512 + (size_t)pr * 512; }
    if (MT == 3) {
        const int sr = 32 * t;
        e.sak = p.out + O_SAK + (size_t)l * 128 * 128 + (size_t)sr * 128; e.sav = p.out + O_SAV + (size_t)l * 128 * 128 + (size_t)sr * 128;
        e.sbk = p.out + O_SBK + (size_t)l * 128 * 512 + (size_t)sr * 512; e.sbv = p.out + O_SBV + (size_t)l * 128 * 512 + (size_t)sr * 512;
    }
    gemm64<1024, MT>((const bf16_t*)(ws + OFF_XB) + (size_t)row0 * DM, DM, d2, wp(p, l, PW_IN), DIN / UW, lds, e);
#if DUP >= 2
    gemm64<1024, MT, EpiNull, DUP - 2>((const bf16_t*)(ws + OFF_XB) + (size_t)row0 * DM, DM, d2, wp(p, l, PW_IN), DIN / UW, lds, EpiNull{p.out});
#endif
}

DI void mem_kv_unit(const Params& p, int e, unsigned char* lds) {
    const int l = e >> 3, kv = (e >> 2) & 1, rt = e & 3;
    unsigned char* ws = p.ws;
    EpiMemKV ep;
    ep.kp = (bf16_t*)(ws + OFF_MK) + (size_t)l * 256 * 512;
    ep.vp = (bf16_t*)(ws + OFF_MVT) + (size_t)l * 256 * 512;
    ep.tb0 = rt * 2;
    ep.o = p.out + (kv ? O_PMV : O_PMK) + (size_t)l * 256 * 512 + (size_t)rt * 64 * 512;
    ep.isv = kv;
    gemm64<1024, 2>((const bf16_t*)(ws + OFF_MEMB) + (size_t)rt * 64 * DM, DM, 0, (const bf16_t*)(ws + OFF_UHALO) + (size_t)(l * 2 + kv) * 512 * 1024, 512 / UW, lds, ep);
}

template <int MT> DI void phaseB(const Params& p, int l, int t, unsigned char* lds) {
    const int row0 = t * 64, d2 = MT == 3 ? tile_d2(t) : 0, tid = otid(), wave = __builtin_amdgcn_readfirstlane(tid >> 6);
    unsigned char* ws = p.ws;
    bf16_t* priv = (bf16_t*)(ws + OFF_PRIV) + (size_t)row0 * PRIVW;
    bf16_t* xb = (bf16_t*)(ws + OFF_XB) + (size_t)row0 * DM;
    float* x = p.out + (size_t)row0 * DM;
    const bf16_t* KA = (const bf16_t*)(ws + OFF_KA); const bf16_t* VTA = (const bf16_t*)(ws + OFF_VTA);
    const bf16_t* KB = (const bf16_t*)(ws + OFF_KB); const bf16_t* VTB = (const bf16_t*)(ws + OFF_VTB);
    float* rel = (float*)lds;
    __syncthreads();
    for (int i = tid; i < 8 * 513; i += NTHR) rel[i] = p.in[13][(size_t)l * 8 * 513 + i];
    __syncthreads();
    const float* sink = p.in[12] + l * 8;
    for (int rep_ = 0; rep_ < (DUP == 1 ? 2 : 1); ++rep_)
    for (int it = wave; it < (MT == 3 ? 64 : 32); it += NWAVE) {
        if (it < 32) {
            const int c = t, isB = it >> 4, hq = (it >> 1) & 7, qh = it & 1;
            if (!isB) {
                const int kvh = hq >> 2, c0 = c - 2 < 0 ? 0 : c - 2;
                attn_item<64, 1>(priv + (size_t)(32 * qh) * PRIVW + PC_QA + hq * 64, PRIVW, 32, row0 + 32 * qh,
                                 KA + (size_t)(2 * c0) * 4096 + kvh * 2048, 4096, VTA + (size_t)(2 * c0) * 4096 + kvh * 2048, 4096, c - c0 + 1, 64 * c0,
                                 nullptr, nullptr, 0, 0, 0,
                                 sink[hq], 1.f, exp2f(-(float)(hq + 1)), nullptr, priv + (size_t)(32 * qh) * PRIVW + PC_OA + hq * 64, PRIVW);
            } else {
                const int c0 = c - 8 < 0 ? 0 : c - 8;
                attn_item<64, 2>(priv + (size_t)(32 * qh) * PRIVW + PC_QB + hq * 64, PRIVW, 32, row0 + 32 * qh,
                                 KB + (size_t)(2 * c0) * 16384 + hq * 2048, 16384, VTB + (size_t)(2 * c0) * 16384 + hq * 2048, 16384, c - c0 + 1, 64 * c0,
                                 nullptr, nullptr, 0, 0, 0,
                                 -1e30f, 0.f, 0.f, rel + hq * 513, priv + (size_t)(32 * qh) * PRIVW + PC_OB + hq * 64, PRIVW);
            }
        } else {
            const int j = it - 32, isB = j >> 4, bb = (j >> 3) & 1, hq = j & 7, b = 2 * t + bb;
            const size_t nrow = (size_t)SEQ + b * 16;
            const int tbn = SEQ / 32 + t, koff = bb * 16;
            bf16_t* sp = (bf16_t*)(ws + OFF_PRIV) + nrow * PRIVW;
            if (!isB) {
                const int kvh = hq >> 2;
                attn_item<64, 1>(sp + PC_QA + hq * 64, PRIVW, 16, 1024,
                                 (const bf16_t*)(ws + OFF_SKA) + (size_t)b * 16384 + kvh * 2048, 4096, (const bf16_t*)(ws + OFF_SVTA) + (size_t)b * 16384 + kvh * 2048, 4096, 2, 896,
                                 KA + (size_t)tbn * 4096 + kvh * 2048, VTA + (size_t)tbn * 4096 + kvh * 2048, 1, 1024, koff,
                                 sink[hq], 1.f, exp2f(-(float)(hq + 1)), nullptr, sp + PC_OA + hq * 64, PRIVW);
            } else {
                attn_item<64, 2>(sp + PC_QB + hq * 64, PRIVW, 16, 1024,
                                 (const bf16_t*)(ws + OFF_SKB) + (size_t)b * 262144 + hq * 2048, 16384, (const bf16_t*)(ws + OFF_SVTB) + (size_t)b * 262144 + hq * 2048, 16384, 8, 512,
                                 KB + (size_t)tbn * 16384 + hq * 2048, VTB + (size_t)tbn * 16384 + hq * 2048, 1, 1024, koff,
                                 -1e30f, 0.f, 0.f, rel + hq * 513, sp + PC_OB + hq * 64, PRIVW);
            }
        }
    }
    gemm64<512, MT>(priv + PC_OA, PRIVW, d2, wp(p, l, PW_OA), DM / UW, lds, EpiGate<MT, 0>{priv, PC_GA, d2});
    gemm64<512, MT>(priv + PC_OB, PRIVW, d2, wp(p, l, PW_OB), DM / UW, lds, EpiGate<MT, 1>{priv, PC_GB, d2});
    gemm64<1024, MT>(priv + PC_M, PRIVW, d2, wp(p, l, PW_OUT), DM / UW, lds, EpiResid<MT>{x, d2});
    __syncthreads();
    norm_rows<1, MT>(nullptr, nullptr, x, d2, xb, nullptr);
    gemm64<1024, MT>(xb, DM, d2, wp(p, l, PW_XQ), 512 / UW, lds, EpiStore<MT>{priv, PRIVW, PC_QX, d2});
    __syncthreads();
    for (int rep_ = 0; rep_ < (DUP == 1 ? 2 : 1); ++rep_)
    for (int it = wave; it < (MT == 3 ? 16 : 8); it += NWAVE) {
        if (it < 8) {
            const int hx = it >> 1, qh = it & 1;
            attn_item<128, 0>(priv + (size_t)(32 * qh) * PRIVW + PC_QX + hx * 128, PRIVW, 32, 0,
                              (const bf16_t*)(ws + OFF_MK) + (size_t)l * 131072 + hx * 4096, 16384, (const bf16_t*)(ws + OFF_MVT) + (size_t)l * 131072 + hx * 4096, 16384, 4, 0,
                              nullptr, nullptr, 0, 0, 0,
                              -1e30f, 0.f, 0.f, nullptr, priv + (size_t)(32 * qh) * PRIVW + PC_OX + hx * 128, PRIVW);
        } else {
            const int j = it - 8, bb = j >> 2, hx = j & 3, b = 2 * t + bb;
            bf16_t* sp = (bf16_t*)(ws + OFF_PRIV) + ((size_t)SEQ + b * 16) * PRIVW;
            attn_item<128, 0>(sp + PC_QX + hx * 128, PRIVW, 16, 0,
                              (const bf16_t*)(ws + OFF_SMK) + (size_t)b * 131072 + hx * 4096, 16384, (const bf16_t*)(ws + OFF_SMVT) + (size_t)b * 131072 + hx * 4096, 16384, 4, 0,
                              nullptr, nullptr, 0, 0, 0,
                              -1e30f, 0.f, 0.f, nullptr, sp + PC_OX + hx * 128, PRIVW);
        }
    }
    gemm64<512, MT>(priv + PC_OX, PRIVW, d2, wp(p, l, PW_XO), DM / UW, lds, EpiResid<MT>{x, d2});
    __syncthreads();
    norm_rows<1, MT>(nullptr, nullptr, x, d2, xb, nullptr);
    EpiUp<MT> eu; eu.priv = priv; eu.d2 = d2;
    eu.halo = (float*)(ws + OFF_UHALO) + (size_t)t * 2 * DFF2;
    eu.pconv = t == NTILE - 1 ? p.out + O_PCONV + (size_t)l * 2 * DFF2 : nullptr;
    eu.sconv = p.out + O_SCONV + ((size_t)l * 8 + 2 * t) * 2 * DFF2;
    gemm64<1024, MT>(xb, DM, d2, wp(p, l, PW_UP), DFF2 / UW, lds, eu);
}

template <int NR> DI void conv_seg(bf16_t* rows, const float* st, const float (&wg)[3][2], const float (&wu)[3][2], const float (&bg)[2], const float (&bu)[2], int j) {
    float g2[2] = {0.f, 0.f}, g1[2] = {0.f, 0.f}, u2[2] = {0.f, 0.f}, u1[2] = {0.f, 0.f};
    if (st) {
        g2[0] = st[j]; g2[1] = st[j + 1]; u2[0] = st[DFF + j]; u2[1] = st[DFF + j + 1];
        g1[0] = st[DFF2 + j]; g1[1] = st[DFF2 + j + 1]; u1[0] = st[DFF2 + DFF + j]; u1[1] = st[DFF2 + DFF + j + 1];
    }
    for (int lb = 0; lb < NR; lb += 8) {
        unsigned gwv[8], uwv[8];
#pragma unroll
        for (int q8 = 0; q8 < 8; ++q8) { const bf16_t* rp = rows + (size_t)(lb + q8) * PRIVW; gwv[q8] = *(const unsigned*)(rp + j); uwv[q8] = *(const unsigned*)(rp + DFF + j); }
#pragma unroll
        for (int q8 = 0; q8 < 8; ++q8) {
            const unsigned gw = gwv[q8], uw = uwv[q8];
            const float g0[2] = {bf2f((bf16_t)(gw & 0xffffu)), bf2f((bf16_t)(gw >> 16))};
            const float u0[2] = {bf2f((bf16_t)(uw & 0xffffu)), bf2f((bf16_t)(uw >> 16))};
            float a[2];
#pragma unroll
            for (int q = 0; q < 2; ++q) {
                const float cg_ = bg[q] + wg[0][q] * g2[q] + wg[1][q] * g1[q] + wg[2][q] * g0[q];
                const float cu_ = bu[q] + wu[0][q] * u2[q] + wu[1][q] * u1[q] + wu[2][q] * u0[q];
                a[q] = cg_ * sigm(cg_) * cu_;
                g2[q] = g1[q]; g1[q] = g0[q]; u2[q] = u1[q]; u1[q] = u0[q];
            }
            *(unsigned*)(rows + (size_t)(lb + q8) * PRIVW + j) = pk2(a[0], a[1]);
        }
    }
}

template <int MT> DI void phaseC(const Params& p, int l, int t, unsigned char* lds) {
    const int row0 = t * 64, d2 = MT == 3 ? tile_d2(t) : 0, tid = otid();
    unsigned char* ws = p.ws;
    bf16_t* priv = (bf16_t*)(ws + OFF_PRIV) + (size_t)row0 * PRIVW;
    bf16_t* xb = (bf16_t*)(ws + OFF_XB) + (size_t)row0 * DM;
    float* x = p.out + (size_t)row0 * DM;
    const float* wc = p.in[25] + (size_t)l * 3 * DFF2;
    const float* bc = p.in[26] + (size_t)l * DFF2;
    __syncthreads();
    for (int jp = tid; jp < DFF / 2; jp += NTHR) {
        const int j = jp * 2;
        float wg[3][2], wu[3][2], bg[2], bu[2];
#pragma unroll
        for (int k = 0; k < 3; ++k) { wg[k][0] = wc[k * DFF2 + j]; wg[k][1] = wc[k * DFF2 + j + 1]; wu[k][0] = wc[k * DFF2 + DFF + j]; wu[k][1] = wc[k * DFF2 + DFF + j + 1]; }
        bg[0] = bc[j]; bg[1] = bc[j + 1]; bu[0] = bc[DFF + j]; bu[1] = bc[DFF + j + 1];
        conv_seg<64>(priv, t > 0 ? (const float*)(ws + OFF_UHALO) + (size_t)(t - 1) * 2 * DFF2 : nullptr, wg, wu, bg, bu, j);
        if (MT == 3) {
            conv_seg<16>(priv + (size_t)(64 + d2) * PRIVW, p.in[9] + ((size_t)l * 8 + 2 * t) * 2 * DFF2, wg, wu, bg, bu, j);
            conv_seg<16>(priv + (size_t)(80 + d2) * PRIVW, p.in[9] + ((size_t)l * 8 + 2 * t + 1) * 2 * DFF2, wg, wu, bg, bu, j);
        }
    }
    gemm64<DFF, MT>(priv, PRIVW, d2, wp(p, l, PW_DOWN), DM / UW, lds, EpiResid<MT>{x, d2});
    __syncthreads();
    if (l == DEPTH - 1) norm_rows<2, MT>(nullptr, nullptr, x, d2, nullptr, p.in[28]);
    else norm_rows<1, MT>(nullptr, nullptr, x, d2, xb, nullptr);
}

DI void pack_layer(const Params& p, int l, int gtid_, int gthreads) {
    int gtid = gtid_; asm volatile("" : "+v"(gtid));
    bf16_t* w = (bf16_t*)(p.ws + OFF_WP) + (size_t)l * PW_LAYER;
    pack_w(p.in[11] + (size_t)l * DM * DIN, p.in[10] + l * DM, DM, DIN, w + PW_IN, 1, gtid, gthreads);
    pack_w(p.in[14] + (size_t)l * 512 * DM, nullptr, 512, DM, w + PW_OA, 0, gtid, gthreads);
    pack_w(p.in[15] + (size_t)l * 512 * DM, nullptr, 512, DM, w + PW_OB, 0, gtid, gthreads);
    pack_w(p.in[16] + (size_t)l * DM * DM, nullptr, DM, DM, w + PW_OUT, 0, gtid, gthreads);
    pack_w(p.in[19] + (size_t)l * DM * 512, p.in[17] + l * DM, DM, 512, w + PW_XQ, 2, gtid, gthreads);
    pack_w(p.in[22] + (size_t)l * 512 * DM, nullptr, 512, DM, w + PW_XO, 0, gtid, gthreads);
    pack_w(p.in[24] + (size_t)l * DM * DFF2, p.in[23] + l * DM, DM, DFF2, w + PW_UP, 0, gtid, gthreads);
    pack_w(p.in[27] + (size_t)l * DFF * DM, nullptr, DFF, DM, w + PW_DOWN, 0, gtid, gthreads);
}

#define XB_TMO      128
#define XB_XCNT(j)  (256  + 64 * (j))
#define XB_XSUB(j)  (1280 + 64 * (j))
#define XB_XGEN(j)  (2304 + 64 * (j))
#define XB_TOP      3328
#define XB_TOPGEN   3392
#define XCD_BAR_WORDS 3456
#define XB_SPIN_CAP (1u << 18)
#define LAS __attribute__((address_space(3)))

__device__ __forceinline__ unsigned xb_ld(unsigned* p)              { return __hip_atomic_load(p, __ATOMIC_RELAXED, __HIP_MEMORY_SCOPE_AGENT); }
__device__ __forceinline__ unsigned xb_add(unsigned* p, unsigned v) { return __hip_atomic_fetch_add(p, v, __ATOMIC_RELAXED, __HIP_MEMORY_SCOPE_AGENT); }
__device__ __forceinline__ unsigned xb_xcc_id() { return (unsigned)__builtin_amdgcn_s_getreg((3 << 11) | 20) & 0xFu; }
#define XB_SPIN(cond, bar) do { unsigned _sp = 0; while (cond) { __builtin_amdgcn_s_sleep(1); \
    if ((++_sp & 255u) == 0u) { if (xb_ld(&(bar)[XB_TMO])) break; if (_sp > XB_SPIN_CAP) { atomicAdd(&(bar)[XB_TMO], 1u); break; } } } } while (0)

struct XcdBarrier {
    unsigned* bar; unsigned x;
    volatile LAS unsigned* st;
};

__device__ __forceinline__ XcdBarrier xcd_barrier_post(unsigned* bar, volatile LAS unsigned* st) {
    XcdBarrier b; b.bar = bar; b.x = xb_xcc_id(); b.st = st;
    if (threadIdx.x == 0) (void)xb_add(&bar[XB_XCNT(b.x)], 1u);
    return b;
}
__device__ __forceinline__ void xcd_barrier_complete(unsigned* bar, unsigned x, unsigned& nloc, unsigned& nx) {
    const unsigned G = gridDim.x * gridDim.y * gridDim.z;
    unsigned sum, cnt, mine, sp = 0u;
    for (;;) {
        sum = 0u; cnt = 0u; mine = 0u;
#pragma unroll
        for (unsigned j = 0; j < 16; ++j) { const unsigned c = xb_ld(&bar[XB_XCNT(j)]); sum += c; cnt += (c > 0u) ? 1u : 0u; mine = (j == x) ? c : mine; }
        if (sum == G) break;
        __builtin_amdgcn_s_sleep(1);
        if ((++sp & 255u) == 0u) { if (xb_ld(&bar[XB_TMO])) break; if (sp > XB_SPIN_CAP) { atomicAdd(&bar[XB_TMO], 1u); break; } }
    }
    nloc = mine > 0u ? mine : 1u; nx = cnt > 0u ? cnt : 1u;
}

__device__ __forceinline__ void xcd_barrier(const XcdBarrier& b) {
    asm volatile("s_waitcnt vmcnt(0)" ::: "memory");
    __syncthreads();
    if (threadIdx.x == 0) {
        unsigned* bar = b.bar;
        __builtin_amdgcn_s_waitcnt(0);
        unsigned nloc = b.st[0], nx = b.st[1];
        if (nloc == 0u) { xcd_barrier_complete(bar, b.x, nloc, nx); b.st[0] = nloc; b.st[1] = nx; }
        const unsigned old = xb_add(&bar[XB_XSUB(b.x)], 1u);
        const unsigned gen = old / nloc;
        if (old + 1u == (gen + 1u) * nloc) {
            __builtin_amdgcn_fence(__ATOMIC_RELEASE, "agent");
            asm volatile("s_waitcnt vmcnt(0)" ::: "memory");
            const unsigned og = xb_add(&bar[XB_TOP], 1u);
            const unsigned tg = og / nx;
            if (og + 1u == (tg + 1u) * nx) xb_add(&bar[XB_TOPGEN], 1u);
            else XB_SPIN(xb_ld(&bar[XB_TOPGEN]) == tg, bar);
            __builtin_amdgcn_fence(__ATOMIC_ACQUIRE, "agent");
            xb_add(&bar[XB_XGEN(b.x)], 1u);
            asm volatile("s_waitcnt vmcnt(0)" ::: "memory");
        } else {
            XB_SPIN(xb_ld(&bar[XB_XGEN(b.x)]) == gen, bar);
            __builtin_amdgcn_fence(__ATOMIC_ACQUIRE, "agent");
            asm volatile("s_waitcnt vmcnt(0)" ::: "memory");
        }
    }
    __syncthreads();
}


__global__ void __launch_bounds__(NTHR) mega(Params p) {
    cg::grid_group grid = cg::this_grid();
    __shared__ __attribute__((aligned(16))) unsigned char lds[LDS_BYTES];
    __shared__ uint4 xb_words;
    if (threadIdx.x == 0) xb_words = make_uint4(0u, 0u, 0u, 0u);
    __syncthreads();
    (void)xcd_barrier_post((unsigned*)(p.ws + OFF_BAR), (volatile LAS unsigned*)&xb_words);
    auto xsync = [&]() { XcdBarrier b; b.bar = (unsigned*)(p.ws + OFF_BAR); b.x = xb_xcc_id(); b.st = (volatile LAS unsigned*)&xb_words; xcd_barrier(b); };
    const int G = gridDim.x, bid = blockIdx.x, tid = threadIdx.x;
    const int gtid = bid * NTHR + tid, gthreads = G * NTHR;
    const int tb = G == NTILE ? (bid & 7) * (NTILE / 8) + (bid >> 3) : bid;
    unsigned char* ws = p.ws;
    pack_layer(p, 0, gtid, gthreads);
    for (int l = 0; l < DEPTH; ++l) {
        pack_w(p.in[20] + (size_t)l * DM * 512, p.in[18] + l * DM, DM, 512, (bf16_t*)(ws + OFF_UHALO) + (size_t)(l * 2 + 0) * 512 * 1024, 0, gtid, gthreads);
        pack_w(p.in[21] + (size_t)l * DM * 512, p.in[18] + l * DM, DM, 512, (bf16_t*)(ws + OFF_UHALO) + (size_t)(l * 2 + 1) * 512 * 1024, 0, gtid, gthreads);
    }
    conv_sample_caches(p, 0, gthreads);
    for (int t = tb; t < NTILE; t += G) {
        const int row0 = t * 64;
        if (t < 4) norm_rows<0, 3>(p.in[0] + (size_t)row0 * DM, p.in[1] + (size_t)(32 * t) * DM, p.out + (size_t)row0 * DM, tile_d2(t), (bf16_t*)(ws + OFF_XB) + (size_t)row0 * DM, nullptr);
    }
    for (int t = tb; t < NTILE; t += G) {
        const int row0 = t * 64;
        if (t >= 4) norm_rows<0, 2>(p.in[0] + (size_t)row0 * DM, p.in[1], p.out + (size_t)row0 * DM, 0, (bf16_t*)(ws + OFF_XB) + (size_t)row0 * DM, nullptr);
    }
    for (int e = tb; e < 8; e += G) if (e >= 4) norm_rows<1, 2>(nullptr, nullptr, (float*)(p.in[2] + (size_t)(e - 4) * 64 * DM), 0, (bf16_t*)(ws + OFF_MEMB) + (size_t)(e - 4) * 64 * DM, nullptr);
    { __syncthreads(); grid.sync(); }
    for (int t = tb; t < NTILE; t += G) if (t < 4) phaseA<3>(p, 0, t, lds);
    for (int t = tb; t < NTILE; t += G) if (t >= 4) phaseA<2>(p, 0, t, lds);
    for (int e = tb; e < 36; e += G) if (e >= 4) mem_kv_unit(p, e - 4, lds);
    xsync();
    for (int l = 0; l < DEPTH; ++l) {
        for (int t = tb; t < NTILE; t += G) if (t < 4) phaseB<3>(p, l, t, lds);
        for (int t = tb; t < NTILE; t += G) if (t >= 4) phaseB<2>(p, l, t, lds);
        if (l + 1 < DEPTH) {
            if (G > 8) { if (tb >= 4) pack_layer(p, l + 1, (tb - 4) * NTHR + otid(), (G - 4) * NTHR); }
            else pack_layer(p, l + 1, bid * NTHR + otid(), G * NTHR);
        }
        xsync();
        if (l + 1 < DEPTH) conv_sample_caches(p, l + 1, gthreads);

        for (int t = tb; t < NTILE; t += G) if (t < 4) { phaseC<3>(p, l, t, lds); if (l + 1 < DEPTH) phaseA<3>(p, l + 1, t, lds); }
        for (int t = tb; t < NTILE; t += G) if (t >= 4) { phaseC<2>(p, l, t, lds); if (l + 1 < DEPTH) phaseA<2>(p, l + 1, t, lds); }
        if (l + 1 < DEPTH) xsync();
    }
}

extern "C" void kernel_launch(void* const* d_in, const int* in_sizes, int n_in, void* d_out, int out_size, void* d_ws, size_t ws_size, hipStream_t stream) {
    static int grid_blocks = 0;
    if (!grid_blocks) {
        int dev = 0, cus = 0, per_cu = 0;
        (void)hipGetDevice(&dev);
        (void)hipDeviceGetAttribute(&cus, hipDeviceAttributeMultiprocessorCount, dev);
        (void)hipOccupancyMaxActiveBlocksPerMultiprocessor(&per_cu, mega, NTHR, 0);
        grid_blocks = cus * per_cu;
        if (grid_blocks > NTILE) grid_blocks = NTILE;
        if (grid_blocks < 1) grid_blocks = 1;
    }
    if (ws_size < WS_TOTAL || n_in < 29) { fprintf(stderr, "workspace too small: %zu < %zu\n", ws_size, (size_t)WS_TOTAL); return; }
    Params p{};
    for (int i = 0; i < 29; ++i) p.in[i] = (const float*)d_in[i];
    p.out = (float*)d_out;
    p.ws = (unsigned char*)d_ws;
    (void)hipMemsetAsync((unsigned char*)d_ws + OFF_BAR, 0, 16384, stream);
    void* args[] = {&p};
    hipError_t e = hipLaunchCooperativeKernel((void*)mega, dim3(grid_blocks), dim3(NTHR), args, 0, stream);
    if (e != hipSuccess) fprintf(stderr, "cooperative launch failed: %s (grid %d)\n", hipGetErrorString(e), grid_blocks);
}
```
